# Optimizing an MI355X kernel written in HIP

```python
import math
import jax
import jax.numpy as jnp
from jax import lax
import numpy as np

D_MODEL = 1024
BATCH = 2
SEQ = 8192
DEPTH = 4
DEC_BATCH = 128
DEC_SEQ = 8
PAST_LEN = 8192
PAGE_SIZE = 128

HEAD_DIM = 64
ATTN_HEADS = D_MODEL // 128
KV_HEADS = max(1, ATTN_HEADS // 4)
Q_PER_KV = ATTN_HEADS // KV_HEADS
ATTN_DIM = ATTN_HEADS * HEAD_DIM
KV_DIM = KV_HEADS * HEAD_DIM
WINDOW = 128
ATTN_BLOCK = WINDOW
MEM_HEADS = 4
MEM_DIM = MEM_HEADS * HEAD_DIM
N_MEM = 256
CONV_DIM = D_MODEL - ATTN_DIM - MEM_DIM
CONV_W = 3
CONV_BUF = CONV_W - 1
MIX_DIM = CONV_DIM + ATTN_DIM + MEM_DIM
IN_DIM = 4 * CONV_DIM + 2 * ATTN_DIM + 2 * KV_DIM + 2 * MEM_DIM
RMS_EPS = 1e-6

kernel_name = "hymba_conv_swa_sink_memxattn_step"


def _rmsnorm(x, g):
    xf = x.astype(jnp.float32)
    r = lax.rsqrt(jnp.mean(xf * xf, axis=-1, keepdims=True) + RMS_EPS)
    return (xf * r).astype(x.dtype) * g


def _split_cols(z):
    sizes = (CONV_DIM, CONV_DIM, CONV_DIM, CONV_DIM,
             ATTN_DIM, KV_DIM, KV_DIM, ATTN_DIM, MEM_DIM, MEM_DIM)
    idx, acc = [], 0
    for s in sizes[:-1]:
        acc += s
        idx.append(acc)
    return jnp.split(z, idx, axis=-1)


def _sink_attend(q, k, v, sink, mask):
    s = jnp.einsum('...qkgd,...skd->...kgqs', q, k).astype(jnp.float32) * (HEAD_DIM ** -0.5)
    s = jnp.where(mask, s, -jnp.inf)
    sk = sink.astype(jnp.float32)[:, :, None]
    m = jnp.maximum(jnp.max(s, axis=-1), sk)
    p = jnp.exp(s - m[..., None])
    p = p / (jnp.sum(p, axis=-1) + jnp.exp(sk - m))[..., None]
    return jnp.einsum('...kgqs,...skd->...qkgd', p.astype(v.dtype), v)


def _window_prompt(q, k, v, sink):
    b, s = q.shape[0], q.shape[1]
    nb = s // ATTN_BLOCK
    qb = q.reshape(b, nb, ATTN_BLOCK, KV_HEADS, Q_PER_KV, HEAD_DIM)
    kb = k.reshape(b, nb, ATTN_BLOCK, KV_HEADS, HEAD_DIM)
    vb = v.reshape(b, nb, ATTN_BLOCK, KV_HEADS, HEAD_DIM)
    kk = jnp.concatenate([jnp.concatenate([jnp.zeros_like(kb[:, :1]), kb[:, :-1]], axis=1), kb], axis=2)
    vv = jnp.concatenate([jnp.concatenate([jnp.zeros_like(vb[:, :1]), vb[:, :-1]], axis=1), vb], axis=2)
    a = jnp.arange(ATTN_BLOCK)[:, None]
    j = jnp.arange(2 * ATTN_BLOCK)[None, :]
    diff = a + ATTN_BLOCK - j
    blk = jnp.arange(nb)[:, None, None]
    valid_key = (blk * ATTN_BLOCK + j[None] - ATTN_BLOCK) >= 0
    mask = (diff >= 0)[None] & (diff < WINDOW)[None] & valid_key
    o = _sink_attend(qb, kk, vv, sink, mask[None, :, None, None])
    return o.reshape(b, s, ATTN_DIM)


def _window_sample(q, k, v, buf_k, buf_v, sink):
    n, t = q.shape[0], q.shape[1]
    kk = jnp.concatenate([buf_k, k], axis=1)
    vv = jnp.concatenate([buf_v, v], axis=1)
    i = jnp.arange(t)[:, None]
    j = jnp.arange(WINDOW + t)[None, :]
    diff = i + WINDOW - j
    mask = (diff >= 0) & (diff < WINDOW)
    o = _sink_attend(q, kk, vv, sink, mask)
    return o.reshape(n, t, ATTN_DIM), kk[:, -WINDOW:], vv[:, -WINDOW:]


def _mem_attend(q, mk, mv):
    s = jnp.einsum('nthd,nmhd->nhtm', q, mk).astype(jnp.float32) * (HEAD_DIM ** -0.5)
    p = jax.nn.softmax(s, axis=-1)
    o = jnp.einsum('nhtm,nmhd->nthd', p.astype(mv.dtype), mv)
    return o.reshape(q.shape[0], q.shape[1], MEM_DIM)


def _layer(x, conv_buf, buf_k, buf_v, mem_k, mem_v, g_pre, g_post, w_in, conv_w, sink, w_out, prompt):
    n, t = x.shape[0], x.shape[1]
    h = _rmsnorm(x, g_pre)
    z = h @ w_in
    cb, cc, ch, cg, q, k, v, ag, mq, mg = _split_cols(z)
    u = cc * ch
    up = jnp.concatenate([conv_buf, u], axis=1)
    conv = conv_w[0] * up[:, 0:t] + conv_w[1] * up[:, 1:t + 1] + conv_w[2] * up[:, 2:t + 2]
    out_a = jax.nn.silu(cg) * cb * conv
    new_conv = up[:, -CONV_BUF:]
    q = q.reshape(n, t, KV_HEADS, Q_PER_KV, HEAD_DIM)
    k = k.reshape(n, t, KV_HEADS, HEAD_DIM)
    v = v.reshape(n, t, KV_HEADS, HEAD_DIM)
    sink_g = sink.reshape(KV_HEADS, Q_PER_KV)
    if prompt:
        o_b = _window_prompt(q, k, v, sink_g)
        new_k, new_v = k[:, -WINDOW:], v[:, -WINDOW:]
    else:
        o_b, new_k, new_v = _window_sample(q, k, v, buf_k, buf_v, sink_g)
    out_b = jax.nn.silu(ag) * o_b
    o_c = _mem_attend(mq.reshape(n, t, MEM_HEADS, HEAD_DIM), mem_k, mem_v)
    out_c = jax.nn.silu(mg) * o_c
    y = jnp.concatenate([out_a, out_b, out_c], axis=-1) @ w_out
    return x + _rmsnorm(y, g_post), new_conv, new_k, new_v


def setup_inputs(seed: int = 0) -> dict:
    key = jax.random.key(seed)
    ks = jax.random.split(key, 20)
    f32 = jnp.float32
    nrm = lambda k, shp, sc: jax.random.normal(k, shp, f32) * sc
    return {
        "x_prompt": nrm(ks[0], (BATCH, SEQ, D_MODEL), 1.0),
        "x_sample": nrm(ks[1], (DEC_BATCH, DEC_SEQ, D_MODEL), 1.0),
        "mem_prompt": nrm(ks[2], (BATCH, N_MEM, D_MODEL), 1.0),
        "cache_win_k": nrm(ks[3], (DEPTH, DEC_BATCH, WINDOW, KV_HEADS, HEAD_DIM), 1.0),
        "cache_win_v": nrm(ks[4], (DEPTH, DEC_BATCH, WINDOW, KV_HEADS, HEAD_DIM), 1.0),
        "state_conv": nrm(ks[5], (DEPTH, DEC_BATCH, CONV_BUF, CONV_DIM), 1.0),
        "cache_mem_k": nrm(ks[6], (DEPTH, DEC_BATCH, N_MEM, MEM_HEADS, HEAD_DIM), 1.0),
        "cache_mem_v": nrm(ks[7], (DEPTH, DEC_BATCH, N_MEM, MEM_HEADS, HEAD_DIM), 1.0),
        "norm_pre": 1.0 + nrm(ks[8], (DEPTH, D_MODEL), 0.05),
        "norm_post": 1.0 + nrm(ks[9], (DEPTH, D_MODEL), 0.05),
        "norm_mem": 1.0 + nrm(ks[10], (DEPTH, D_MODEL), 0.05),
        "w_in": nrm(ks[11], (DEPTH, D_MODEL, IN_DIM), D_MODEL ** -0.5),
        "conv_w": nrm(ks[12], (DEPTH, CONV_W, CONV_DIM), CONV_W ** -0.5),
        "attn_sinks": nrm(ks[13], (DEPTH, ATTN_HEADS), 0.5),
        "w_mem_kv": nrm(ks[14], (DEPTH, D_MODEL, 2 * MEM_DIM), D_MODEL ** -0.5),
        "w_out": nrm(ks[15], (DEPTH, MIX_DIM, D_MODEL), MIX_DIM ** -0.5),
    }


def reference(x_prompt, x_sample, mem_prompt, cache_win_k, cache_win_v, state_conv,
              cache_mem_k, cache_mem_v, norm_pre, norm_post, norm_mem, w_in, conv_w,
              attn_sinks, w_mem_kv, w_out):
    xp, xs = x_prompt, x_sample
    bp, m = mem_prompt.shape[0], mem_prompt.shape[1]
    wkp, wvp, cvp, mkp, mvp, wks, wvs, cvs = [], [], [], [], [], [], [], []
    for l in range(DEPTH):
        mkv = _rmsnorm(mem_prompt, norm_mem[l]) @ w_mem_kv[l]
        mk = mkv[..., :MEM_DIM].reshape(bp, m, MEM_HEADS, HEAD_DIM)
        mv = mkv[..., MEM_DIM:].reshape(bp, m, MEM_HEADS, HEAD_DIM)
        zero_buf = jnp.zeros((xp.shape[0], CONV_BUF, CONV_DIM), xp.dtype)
        xp, cb_p, k_p, v_p = _layer(xp, zero_buf, None, None, mk, mv, norm_pre[l], norm_post[l],
                                    w_in[l], conv_w[l], attn_sinks[l], w_out[l], True)
        xs, cb_s, k_s, v_s = _layer(xs, state_conv[l], cache_win_k[l], cache_win_v[l],
                                    cache_mem_k[l], cache_mem_v[l], norm_pre[l], norm_post[l],
                                    w_in[l], conv_w[l], attn_sinks[l], w_out[l], False)
        wkp.append(k_p); wvp.append(v_p); cvp.append(cb_p); mkp.append(mk); mvp.append(mv)
        wks.append(k_s); wvs.append(v_s); cvs.append(cb_s)
    return (xp, xs, jnp.stack(wkp), jnp.stack(wvp), jnp.stack(cvp), jnp.stack(mkp), jnp.stack(mvp),
            jnp.stack(wks), jnp.stack(wvs), jnp.stack(cvs))
```

```cpp
#include <hip/hip_runtime.h>
#include <hip/hip_cooperative_groups.h>
#include <cstdio>
#include <cstdint>
namespace cg = cooperative_groups;
namespace pg8 {
#define PG8_LAS __attribute__((address_space(3)))
typedef unsigned short bf16_t;
typedef short bf16x8 __attribute__((ext_vector_type(8)));
typedef float f32x4 __attribute__((ext_vector_type(4)));
typedef unsigned u32x4 __attribute__((ext_vector_type(4)));
constexpr int BM = 256, BK = 64, HALF = 128, HTB = HALF * BK * 2  , STAGE_BYTES = 8 * HTB, NXCD = 8, WGM = 8;

__host__ __device__ __forceinline__ int lds_byte(int r, int c) { const int st = (r >> 4) * 2 + (c >> 5), rr = r & 15, cc = c & 31, ob = rr * 64 + cc * 2; return st * 1024 + (ob ^ (((ob >> 9) & 1) << 5)); }
__host__ __device__ __forceinline__ void stage_rc(int b, int& R, int& C) { const int st = b / 1024, sb = b % 1024, swz = sb ^ (((sb >> 9) & 1) << 5); R = (st >> 1) * 16 + swz / 64; C = (st & 1) * 32 + (swz % 64) / 2; }
__host__ __device__ __forceinline__ int perm32(int rho) { const int n = rho >> 4, i = rho & 15; return 8 * (i >> 2) + 4 * n + (i & 3); }

struct Unit { int pm, pn; };
struct Gemm { const bf16_t* A; const bf16_t* Bt; int M, N, K; };

struct StaticOrder {
    int nM, nN, nwg, G, c;
    __host__ __device__ void init(int M, int N, int G_, int c_) { nM = M / BM; nN = N / BM; nwg = nM * nN; G = G_; c = c_; }
    __host__ __device__ bool next(int i, Unit& u) const {
        const long L = (long)i * G + c; if (L >= nwg) return false;
        int wgid = (int)L; { const int q = nwg / NXCD, r = nwg % NXCD, xcd = wgid % NXCD, off = wgid / NXCD; wgid = (xcd < r ? xcd * (q + 1) : r * (q + 1) + (xcd - r) * q) + off; }
        const int nig = WGM * nN, gid = wgid / nig, fm = gid * WGM, gsz = (nM - fm) < WGM ? (nM - fm) : WGM;
        u.pm = fm + ((wgid % nig) % gsz); u.pn = (wgid % nig) / gsz; return true;
    }
    __device__ __forceinline__ void a_ready(const Unit&) const {}
    __device__ __forceinline__ void done(const Unit&) const {}
};

__device__ __forceinline__ unsigned cvt_pk_bf16(float lo, float hi) { unsigned r; asm volatile("v_cvt_pk_bf16_f32 %0, %1, %2" : "=v"(r) : "v"(lo), "v"(hi)); return r; }
typedef float f32x2 __attribute__((ext_vector_type(2)));
typedef unsigned u32x2 __attribute__((ext_vector_type(2)));
__device__ __forceinline__ float silu_f(float v) { return v * __builtin_amdgcn_rcpf(1.0f + __builtin_amdgcn_exp2f(-1.4426950408889634f * v)); }
struct EpiZ {
    static constexpr bool PERM = true, AFTER_DRAIN = false;
    bf16_t* Z; const float* rs; int ldc;
    __device__ __forceinline__ void operator()(const f32x4 (&acc)[2][2][4][2], const Unit& u, int wr, int wc, int fr, int fq) const {
        const int row0 = u.pm * BM + wr * 64 + fr, col0 = u.pn * BM + wc * 32 + 8 * fq;
        const bool gate = (u.pn == 3) || (u.pn == 7) || (u.pn == 8) || (u.pn == 10);
#pragma unroll
        for (int ai = 0; ai < 2; ++ai)
#pragma unroll
            for (int m = 0; m < 4; ++m) { const int row = row0 + ai * HALF + m * 16; const float sc = rs[row]; bf16_t* rowp = Z + (size_t)row * ldc + col0;
#pragma unroll
                for (int bj = 0; bj < 2; ++bj) { f32x4 v0 = acc[ai][bj][m][0] * sc, v1 = acc[ai][bj][m][1] * sc;
                    if (gate) {
#pragma unroll
                        for (int e = 0; e < 4; ++e) { v0[e] = silu_f(v0[e]); v1[e] = silu_f(v1[e]); } }
                    u32x4 w; w.x = cvt_pk_bf16(v0[0], v0[1]); w.y = cvt_pk_bf16(v0[2], v0[3]); w.z = cvt_pk_bf16(v1[0], v1[1]); w.w = cvt_pk_bf16(v1[2], v1[3]);
                    *(u32x4*)(rowp + bj * HALF) = w; } }
    }
};
struct EpiMKV {
    static constexpr bool PERM = false, AFTER_DRAIN = false;
    float* outK; size_t kv_stride; bf16_t* MKV; const float* rsm;
    __device__ __forceinline__ void operator()(const f32x4 (&acc)[2][2][4][2], const Unit& u, int wr, int wc, int fr, int fq) const {
        const int row0 = u.pm * BM + wr * 64 + fr, col0 = u.pn * BM + wc * 32 + 4 * fq;
#pragma unroll
        for (int ai = 0; ai < 2; ++ai)
#pragma unroll
            for (int m = 0; m < 4; ++m) { const int row = row0 + ai * HALF + m * 16; const float sc = rsm[row]; const int b = row >> 8, mm = row & 255;
#pragma unroll
                for (int bj = 0; bj < 2; ++bj)
#pragma unroll
                    for (int n = 0; n < 2; ++n) { const int c = col0 + bj * HALF + n * 16, l = c >> 9, cc = c & 511; const f32x4 v = acc[ai][bj][m][n] * sc;
                        float* o = outK + (size_t)(cc >> 8) * kv_stride + ((size_t)((l * 2 + b) * 256 + mm)) * 256 + (cc & 255); *(f32x4*)o = v;
                        u32x2 w; w.x = cvt_pk_bf16(v[0], v[1]); w.y = cvt_pk_bf16(v[2], v[3]); *(u32x2*)(MKV + ((size_t)(l * 512 + row)) * 512 + cc) = w; } }
    }
};
struct EpiY {
    static constexpr bool PERM = false, AFTER_DRAIN = false;
    float* Y; int ldc;
    __device__ __forceinline__ void operator()(const f32x4 (&acc)[2][2][4][2], const Unit& u, int wr, int wc, int fr, int fq) const {
        const int row0 = u.pm * BM + wr * 64 + fr, col0 = u.pn * BM + wc * 32 + 4 * fq;
#pragma unroll
        for (int ai = 0; ai < 2; ++ai)
#pragma unroll
            for (int m = 0; m < 4; ++m) { float* rowp = Y + (size_t)(row0 + ai * HALF + m * 16) * ldc + col0;
#pragma unroll
                for (int bj = 0; bj < 2; ++bj)
#pragma unroll
                    for (int n = 0; n < 2; ++n) *(f32x4*)(rowp + bj * HALF + n * 16) = acc[ai][bj][m][n]; }
    }
};
struct MkvOrder {
    int c;
    __host__ __device__ bool next(int i, Unit& u) const { if (i > 0 || c < 0) return false; const int k = c; u.pm = k & 1; u.pn = k >> 1; return true; }
    __device__ __forceinline__ void a_ready(const Unit&) const {}
    __device__ __forceinline__ void done(const Unit&) const {}
};
template <class Epi, class Sched, bool ALIGN_EPI = false, bool SP2 = false>
__device__ __forceinline__ void gemm_phase(PG8_LAS unsigned char* lds, const Gemm g, const Sched& S, const Epi& E) {
    int tid_ = threadIdx.x; asm volatile("" : "+v"(tid_));
    const int tid = tid_, wid = __builtin_amdgcn_readfirstlane(tid >> 6), lane = tid & 63, wr = wid >> 2, wc = wid & 3, fr = lane & 15, fq = lane >> 4;
    const int K = g.K, nt = K / BK;
    unsigned voffA[2], voffB[2];
#pragma unroll
    for (int i = 0; i < 2; ++i) { int R, C; stage_rc(tid * 16 + i * 8192, R, C); const int Rb = Epi::PERM ? ((R & ~31) + perm32(R & 31)) : R;
        voffA[i] = (unsigned)(R * K + C) * 2u; voffB[i] = (unsigned)(Rb * K + C) * 2u; }
    const size_t kstep = (size_t)(BK * 2);
    const size_t hstep = (size_t)HALF * K * 2;
    const size_t tstep = 2 * hstep;
    const unsigned ldsw = (unsigned)wid * 1024u;
    const int aoff = lds_byte(wr * 64 + fr, fq * 8), boff = lds_byte(wc * 32 + fr, fq * 8);
#define PG8_SA(b, h) (((b) * 2 + (h)) * HTB)
#define PG8_SB(b, h) ((4 + (b) * 2 + (h)) * HTB)
#define PG8_STAGE(bufoff, gbase, voff) do { _Pragma("unroll") for (int _i = 0; _i < 2; ++_i) \
        __builtin_amdgcn_global_load_lds((const unsigned*)((const char*)(gbase) + (voff)[_i]), (PG8_LAS unsigned*)(lds + (bufoff) + ldsw + _i * 8192), 16, 0, 0); } while (0)
#define PG8_LDA(dst, b, h) do { _Pragma("unroll") for (int m = 0; m < 4; ++m) _Pragma("unroll") for (int k = 0; k < 2; ++k) dst[m][k] = *(const PG8_LAS bf16x8*)(lds + PG8_SA(b, h) + aoff + m * 2048 + k * 1024); } while (0)
#define PG8_LDB(dst, b, h) do { _Pragma("unroll") for (int n = 0; n < 2; ++n) _Pragma("unroll") for (int k = 0; k < 2; ++k) dst[n][k] = *(const PG8_LAS bf16x8*)(lds + PG8_SB(b, h) + boff + n * 2048 + k * 1024); } while (0)
#define PG8_MMA(ai, bj, At, Bt) do { __builtin_amdgcn_s_setprio(1); _Pragma("unroll") for (int m = 0; m < 4; ++m) _Pragma("unroll") for (int n = 0; n < 2; ++n) _Pragma("unroll") for (int k = 0; k < 2; ++k) \
        acc[ai][bj][m][n] = __builtin_amdgcn_mfma_f32_16x16x32_bf16(Bt[n][k], At[m][k], acc[ai][bj][m][n], 0, 0, 0); __builtin_amdgcn_s_setprio(0); } while (0)
#define PG8_WAIT_V(n) asm volatile("s_waitcnt vmcnt(" #n ")" ::: "memory")
#define PG8_WAIT_L(n) asm volatile("s_waitcnt lgkmcnt(" #n ")" ::: "memory")
#define PG8_BAR __builtin_amdgcn_s_barrier()
#define PG8_SCHED __builtin_amdgcn_sched_barrier(0)
    Unit cur, nxt; int ui = 0;
    if (!S.next(0, cur)) return;
    f32x4 acc[2][2][4][2];
#pragma unroll
    for (int a = 0; a < 2; ++a)
#pragma unroll
        for (int b = 0; b < 2; ++b)
#pragma unroll
            for (int m = 0; m < 4; ++m)
#pragma unroll
                for (int n = 0; n < 2; ++n) acc[a][b][m][n] = (f32x4){0.f, 0.f, 0.f, 0.f};
    bf16x8 At[4][2], B0[2][2], B1[2][2];
    const char* cA = (const char*)g.A + (size_t)cur.pm * tstep; const char* cB = (const char*)g.Bt + (size_t)cur.pn * tstep;
    S.a_ready(cur);
    if constexpr (SP2) {
        PG8_STAGE(PG8_SB(0, 0), cB, voffB); PG8_STAGE(PG8_SB(0, 1), cB + hstep, voffB); PG8_STAGE(PG8_SA(0, 0), cA, voffA); PG8_STAGE(PG8_SA(0, 1), cA + hstep, voffA);
        if (wr == 1) PG8_BAR;
        PG8_WAIT_V(2); PG8_BAR;
        PG8_STAGE(PG8_SB(1, 0), cB + kstep, voffB); PG8_STAGE(PG8_SA(1, 0), cA + kstep, voffA); PG8_STAGE(PG8_SB(1, 1), cB + hstep + kstep, voffB);
        PG8_WAIT_V(6); PG8_BAR;
    } else {
        PG8_STAGE(PG8_SB(0, 0), cB, voffB); PG8_STAGE(PG8_SA(0, 0), cA, voffA); PG8_STAGE(PG8_SB(0, 1), cB + hstep, voffB); PG8_STAGE(PG8_SA(0, 1), cA + hstep, voffA);
        if (wr == 1) PG8_BAR;
        PG8_WAIT_V(4); PG8_BAR;
        PG8_STAGE(PG8_SB(1, 0), cB + kstep, voffB); PG8_STAGE(PG8_SA(1, 0), cA + kstep, voffA); PG8_STAGE(PG8_SB(1, 1), cB + hstep + kstep, voffB);
        PG8_WAIT_V(6); PG8_BAR;
    }
    for (;;) {
        const bool has_next = S.next(ui + 1, nxt);
        const char* nA = has_next ? (const char*)g.A + (size_t)nxt.pm * tstep : cA; const char* nB = has_next ? (const char*)g.Bt + (size_t)nxt.pn * tstep : cB;
        for (int t = 0; t < nt; t += 2) {
            const bool last = (t == nt - 2);
            const char* a1 = cA + (size_t)(t + 1) * kstep;
            const char* a2 = last ? nA : cA + (size_t)(t + 2) * kstep; const char* b2 = last ? nB : cB + (size_t)(t + 2) * kstep;
            const char* a3 = a2 + kstep; const char* b3 = b2 + kstep;
            if (last && has_next) S.a_ready(nxt);
            if constexpr (SP2) {
            PG8_LDB(B0, 0, 0); PG8_LDB(B1, 0, 1); PG8_SCHED; PG8_LDA(At, 0, 0); PG8_STAGE(PG8_SA(1, 1), a1 + hstep, voffA);
            PG8_WAIT_V(8); PG8_WAIT_L(0); PG8_BAR; PG8_MMA(0, 0, At, B0); PG8_MMA(0, 1, At, B1); PG8_BAR; PG8_SCHED;
            PG8_LDA(At, 0, 1); PG8_STAGE(PG8_SB(0, 0), b2, voffB); PG8_STAGE(PG8_SB(0, 1), b2 + hstep, voffB); PG8_STAGE(PG8_SA(0, 0), a2, voffA);
            PG8_WAIT_V(8); PG8_WAIT_L(0); PG8_BAR; PG8_MMA(1, 0, At, B0); PG8_MMA(1, 1, At, B1); PG8_BAR; PG8_SCHED;
            PG8_LDB(B0, 1, 0); PG8_LDB(B1, 1, 1); PG8_SCHED; PG8_LDA(At, 1, 0); PG8_STAGE(PG8_SA(0, 1), a2 + hstep, voffA);
            PG8_WAIT_V(8); PG8_WAIT_L(0); PG8_BAR; PG8_MMA(0, 0, At, B0); PG8_MMA(0, 1, At, B1); PG8_BAR; PG8_SCHED;
            PG8_LDA(At, 1, 1); PG8_STAGE(PG8_SB(1, 0), b3, voffB); PG8_STAGE(PG8_SB(1, 1), b3 + hstep, voffB); PG8_STAGE(PG8_SA(1, 0), a3, voffA);
            PG8_WAIT_V(8); PG8_WAIT_L(0); PG8_BAR; PG8_MMA(1, 0, At, B0); PG8_MMA(1, 1, At, B1); PG8_BAR; PG8_SCHED;
            } else {
            PG8_LDB(B0, 0, 0); PG8_SCHED; PG8_LDA(At, 0, 0); PG8_STAGE(PG8_SA(1, 1), a1 + hstep, voffA);
            PG8_WAIT_L(8); PG8_BAR; PG8_WAIT_L(0); PG8_MMA(0, 0, At, B0); PG8_BAR; PG8_SCHED;
            PG8_LDB(B1, 0, 1); PG8_STAGE(PG8_SB(0, 0), b2, voffB);
            PG8_BAR; PG8_WAIT_L(0); PG8_MMA(0, 1, At, B1); PG8_BAR;
            PG8_LDA(At, 0, 1); PG8_STAGE(PG8_SA(0, 0), a2, voffA);
            PG8_BAR; PG8_WAIT_L(0); PG8_MMA(1, 0, At, B0); PG8_BAR; PG8_SCHED;
            PG8_STAGE(PG8_SB(0, 1), b2 + hstep, voffB);
            PG8_WAIT_V(6); PG8_BAR; PG8_MMA(1, 1, At, B1); PG8_BAR;
            PG8_LDB(B0, 1, 0); PG8_SCHED; PG8_LDA(At, 1, 0); PG8_STAGE(PG8_SA(0, 1), a2 + hstep, voffA);
            PG8_WAIT_L(8); PG8_BAR; PG8_WAIT_L(0); PG8_MMA(0, 0, At, B0); PG8_BAR; PG8_SCHED;
            PG8_LDB(B1, 1, 1); PG8_STAGE(PG8_SB(1, 0), b3, voffB);
            PG8_BAR; PG8_WAIT_L(0); PG8_MMA(0, 1, At, B1); PG8_BAR;
            PG8_LDA(At, 1, 1); PG8_STAGE(PG8_SA(1, 0), a3, voffA);
            PG8_BAR; PG8_WAIT_L(0); PG8_MMA(1, 0, At, B0); PG8_BAR; PG8_SCHED;
            PG8_STAGE(PG8_SB(1, 1), b3 + hstep, voffB);
            PG8_WAIT_V(6); PG8_BAR; PG8_MMA(1, 1, At, B1); PG8_BAR;
            }
        }
        if constexpr (ALIGN_EPI) { if (wr == 0) PG8_BAR; }
        if constexpr (!Epi::AFTER_DRAIN) { E(acc, cur, wr, wc, fr, fq); S.done(cur); }
        if (!has_next) break;
#pragma unroll
        for (int a = 0; a < 2; ++a)
#pragma unroll
            for (int b = 0; b < 2; ++b)
#pragma unroll
                for (int m = 0; m < 4; ++m)
#pragma unroll
                    for (int n = 0; n < 2; ++n) acc[a][b][m][n] = (f32x4){0.f, 0.f, 0.f, 0.f};
        cur = nxt; cA = nA; cB = nB; ++ui;
        if constexpr (ALIGN_EPI) { if (wr == 1) PG8_BAR; }
    }
    PG8_WAIT_V(0);
    if constexpr (!ALIGN_EPI) { if (wr == 0) PG8_BAR; }
    PG8_BAR;
    if constexpr (Epi::AFTER_DRAIN) { E.fused(acc, cur, wr, wc, fr, fq, lds, wid, lane); S.done(cur); }
#undef PG8_SA
#undef PG8_SB
#undef PG8_STAGE
#undef PG8_LDA
#undef PG8_LDB
#undef PG8_MMA
#undef PG8_WAIT_V
#undef PG8_WAIT_L
#undef PG8_BAR
#undef PG8_SCHED
}
}

constexpr int D = 1024, SEQ = 8192, MP = 2 * SEQ, NB = 128, TS = 8, MS = NB * TS, M = MP + MS, NL = 4, IND = 2816, NMEM = 256;
constexpr int ZC_CB = 0, ZC_CC = 256, ZC_CH = 512, ZC_CG = 768, ZC_Q = 1024, ZC_K = 1536, ZC_V = 1664, ZC_AG = 1792, ZC_MQ = 2304, ZC_MG = 2560;
constexpr int MC_A = 0, MC_B = 256, MC_C = 768;
constexpr float RMS_EPS = 1e-6f;
constexpr float LOG2E = 1.4426950408889634f;
constexpr size_t MiB = 1u << 20;
constexpr size_t WS_W1T = 2 * MiB, WS_W2T = 24 * MiB, WS_WMT = 32 * MiB, WS_MEMB = 36 * MiB, WS_RS = 37 * MiB, WS_RSM = WS_RS + 512 * 1024, WS_MKV = 38 * MiB,
                 WS_XB = 40 * MiB, WS_MIX = 74 * MiB, WS_Z = 108 * MiB, WS_Y = 204 * MiB, WS_END = 272 * MiB;
static_assert(WS_W1T + (size_t)NL * IND * D * 2 <= WS_W2T && WS_XB + (size_t)M * D * 2 <= WS_MIX && WS_MIX + (size_t)M * D * 2 <= WS_Z && WS_Z + (size_t)M * IND * 2 <= WS_Y && WS_Y + (size_t)M * D * 4 <= WS_END, "ws map");
constexpr size_t O_X = 0, O_WKP = (size_t)M * D, O_WVP = O_WKP + 131072, O_CVP = O_WVP + 131072, O_MKP = O_CVP + 4096, O_MVP = O_MKP + 524288,
                 O_WKS = O_MVP + 524288, O_WVS = O_WKS + 8388608, O_CVS = O_WVS + 8388608, O_END = O_CVS + 262144;
constexpr int LDS_BYTES = 147456;
constexpr int NWAVES = 8;

#define LAS __attribute__((address_space(3)))
typedef unsigned short bf16;
typedef short bf16x8 __attribute__((ext_vector_type(8)));
typedef short s16x4 __attribute__((ext_vector_type(4)));
typedef short v4i16_t __attribute__((ext_vector_type(4)));
typedef float f32x4 __attribute__((ext_vector_type(4)));
typedef float f32x16 __attribute__((ext_vector_type(16)));
typedef unsigned u32x4 __attribute__((ext_vector_type(4)));
typedef unsigned u32x2 __attribute__((ext_vector_type(2)));
#define LDS_WAIT() asm volatile("s_waitcnt lgkmcnt(0)" ::: "memory")

__device__ __forceinline__ unsigned pk2(float lo, float hi) { typedef float f2_t __attribute__((ext_vector_type(2))); typedef __bf16 b2_t __attribute__((ext_vector_type(2)));
    f2_t v = {lo, hi}; b2_t b = __builtin_convertvector(v, b2_t); return __builtin_bit_cast(unsigned, b); }
__device__ __forceinline__ float bflo(unsigned w) { return __uint_as_float(w << 16); }
__device__ __forceinline__ float bfhi(unsigned w) { return __uint_as_float(w & 0xffff0000u); }
__device__ __forceinline__ float wave_sum(float v) {
#pragma unroll
    for (int o = 1; o < 64; o <<= 1) v += __shfl_xor(v, o);
    return v;
}
__device__ __forceinline__ int crow(int r, int hi) { return (r & 3) + 8 * (r >> 2) + 4 * hi; }
__device__ __forceinline__ s16x4 vtr(const LAS unsigned char* p) { return __builtin_bit_cast(s16x4, __builtin_amdgcn_ds_read_tr16_b64_v4i16((LAS v4i16_t*)p)); }

struct Ctx {
    LAS unsigned char* lds; int tid, lane, wave, G, bid;
    const float *x_prompt, *x_sample, *mem_prompt, *cwk, *cwv, *sconv, *cmk, *cmv, *npre, *npost, *nmem, *w_in, *conv_w, *sinks, *w_mem, *w_out;
    float* out; unsigned char* ws;
    bf16 *W1T, *W2T, *WMT, *MEMB, *MKV, *XB, *MIX, *Z; float *RS, *RSM, *Y;
};

__device__ __forceinline__ void p0_transpose_item(const float* W, const float* g, int K, int N, bf16* WT, LAS float* scr, int item, int lane) {
    const int nblk = N / 32, kb = item / nblk, nb = item % nblk, k0 = 64 * kb, n0 = 32 * nb;
#pragma unroll 8
    for (int i = 0; i < 32; ++i) { const int kk = 2 * i + (lane >> 5); const float sc = g ? g[k0 + kk] : 1.0f; scr[kk * 33 + (lane & 31)] = W[(size_t)(k0 + kk) * N + n0 + (lane & 31)] * sc; }
    LDS_WAIT(); asm volatile("" ::: "memory");
    const int c = lane & 7;
#pragma unroll
    for (int j = 0; j < 4; ++j) { const int n = (lane >> 3) + 8 * j; const LAS float* s = scr + (8 * c) * 33 + n;
        u32x4 o; o.x = pk2(s[0 * 33], s[1 * 33]); o.y = pk2(s[2 * 33], s[3 * 33]); o.z = pk2(s[4 * 33], s[5 * 33]); o.w = pk2(s[6 * 33], s[7 * 33]);
        *(u32x4*)(WT + (size_t)(n0 + n) * K + k0 + 8 * c) = o; }
    LDS_WAIT(); asm volatile("" ::: "memory");
}
__device__ __forceinline__ void row_to_bf16_rs(const float* xrow, bf16* orow, float* rs, int lane) {
    const f32x4* xr = (const f32x4*)xrow + lane; f32x4 v[4]; float s = 0.f;
#pragma unroll
    for (int j = 0; j < 4; ++j) { v[j] = xr[64 * j]; s += (v[j].x * v[j].x + v[j].y * v[j].y) + (v[j].z * v[j].z + v[j].w * v[j].w); }
    s = wave_sum(s);
    if (lane == 0) *rs = 1.0f / sqrtf(s * (1.0f / D) + RMS_EPS);
    u32x2* o8 = (u32x2*)orow + lane;
#pragma unroll
    for (int j = 0; j < 4; ++j) { u32x2 w; w.x = pk2(v[j].x, v[j].y); w.y = pk2(v[j].z, v[j].w); o8[64 * j] = w; }
}
__device__ __forceinline__ void p0_prologue(Ctx& F) {
    LAS float* scr = (LAS float*)(F.lds + F.wave * 16384);
    const int gw = F.bid * NWAVES + F.wave, NGW = F.G * NWAVES;
    constexpr int I_1 = (D / 64) * (IND / 32), I_2 = (D / 64) * (D / 32), I_M = (D / 64) * (512 / 32), I_L = I_1 + I_2 + I_M;
    for (int it = gw; it < NL * I_L; it += NGW) {
        const int l = it / I_L; int r = it % I_L;
        if (r < I_1) { p0_transpose_item(F.w_in + (size_t)l * D * IND, F.npre + l * D, D, IND, F.W1T + (size_t)l * IND * D, scr, r, F.lane); continue; } r -= I_1;
        if (r < I_2) { p0_transpose_item(F.w_out + (size_t)l * D * D, nullptr, D, D, F.W2T + (size_t)l * D * D, scr, r, F.lane); continue; } r -= I_2;
        p0_transpose_item(F.w_mem + (size_t)l * D * 512, F.nmem + l * D, D, 512, F.WMT + (size_t)l * 512 * D, scr, r, F.lane);
    }
    for (int m = gw; m < M + 512; m += NGW) {
        if (m < M) { const float* src = m < MP ? F.x_prompt + (size_t)m * D : F.x_sample + (size_t)(m - MP) * D; row_to_bf16_rs(src, F.XB + (size_t)m * D, F.RS + m, F.lane); }
        else { const int mm = m - M; row_to_bf16_rs(F.mem_prompt + (size_t)mm * D, F.MEMB + (size_t)mm * D, F.RSM + mm, F.lane); }
    }
}

template <int NKB, int MODE>
__device__ __forceinline__ void attn_core(const bf16x8 (&qf)[4], const LAS unsigned char* Kl, int kcs, const LAS unsigned char* Vl, int vhs, float sink2, int nskip, LAS unsigned char* ost, int lane) {
    const int r32 = lane & 31, h = lane >> 5;
    f32x16 s[NKB];
#pragma unroll
    for (int kb = 0; kb < NKB; ++kb) { f32x16 acc = {};
#pragma unroll
        for (int ds = 0; ds < 4; ++ds) { const bf16x8 kf = *(const LAS bf16x8*)(Kl + (2 * ds + h) * kcs + (32 * kb + r32) * 16); acc = __builtin_amdgcn_mfma_f32_32x32x16_bf16(kf, qf[ds], acc, 0, 0, 0); }
        s[kb] = acc; }
    const float C2 = 0.125f * LOG2E, NEG = -INFINITY;
    float mx = sink2; const int t = r32 & 7;
#pragma unroll
    for (int kb = 0; kb < NKB; ++kb)
#pragma unroll
        for (int r = 0; r < 16; ++r) { float v = s[kb][r] * C2; const int key = crow(r, h); bool valid = true;
            if (MODE == 1) { if (kb == 0) valid = key > r32; if (kb == NKB - 1) valid = key <= r32; if (kb < nskip) valid = false; }
            if (MODE == 2) { if (kb == 0) valid = key > t; if (kb == NKB - 1) valid = key <= t; }
            v = valid ? v : NEG; s[kb][r] = v; mx = fmaxf(mx, v); }
    mx = fmaxf(mx, __shfl_xor(mx, 32));
    float sum = 0.f;
#pragma unroll
    for (int kb = 0; kb < NKB; ++kb)
#pragma unroll
        for (int r = 0; r < 16; ++r) { const float p = __builtin_amdgcn_exp2f(s[kb][r] - mx); s[kb][r] = p; sum += p; }
    sum += __shfl_xor(sum, 32); sum += __builtin_amdgcn_exp2f(sink2 - mx);
    const float inv = 1.0f / sum;
    f32x16 o[2]; o[0] = f32x16{}; o[1] = f32x16{};
    const LAS unsigned char* vb = Vl + ((lane >> 4) & 1) * 32 + (lane & 3) * 8 + (4 * h + ((lane & 15) >> 2)) * 64;
#pragma unroll
    for (int kb = 0; kb < NKB; ++kb)
#pragma unroll
        for (int ss = 0; ss < 2; ++ss) {
            u32x4 pw; pw.x = pk2(s[kb][8 * ss + 0], s[kb][8 * ss + 1]); pw.y = pk2(s[kb][8 * ss + 2], s[kb][8 * ss + 3]); pw.z = pk2(s[kb][8 * ss + 4], s[kb][8 * ss + 5]); pw.w = pk2(s[kb][8 * ss + 6], s[kb][8 * ss + 7]);
            const bf16x8 pb = __builtin_bit_cast(bf16x8, pw);
#pragma unroll
            for (int d0 = 0; d0 < 2; ++d0) { const LAS unsigned char* p = vb + d0 * vhs + (32 * kb + 16 * ss) * 64; const s16x4 lo = vtr(p), hi = vtr(p + 512);
                const bf16x8 va = {lo[0], lo[1], lo[2], lo[3], hi[0], hi[1], hi[2], hi[3]};
                o[d0] = __builtin_amdgcn_mfma_f32_32x32x16_bf16(va, pb, o[d0], 0, 0, 0); } }
#pragma unroll
    for (int d0 = 0; d0 < 2; ++d0)
#pragma unroll
        for (int g4 = 0; g4 < 4; ++g4) { u32x2 w; w.x = pk2(o[d0][4 * g4] * inv, o[d0][4 * g4 + 1] * inv); w.y = pk2(o[d0][4 * g4 + 2] * inv, o[d0][4 * g4 + 3] * inv);
            *(LAS u32x2*)(ost + r32 * 144 + (32 * d0 + 8 * g4 + 4 * h) * 2) = w; }
    LDS_WAIT(); asm volatile("" ::: "memory");
}
template <int RM> __device__ __forceinline__ int rm_row(int rowbase, int q) { return RM == 0 ? rowbase + q : rowbase + (q & 7); }
template <int RM> __device__ __forceinline__ int rm_col(int q) { return RM == 1 ? 64 * (q >> 3) : 0; }
template <int RM> __device__ __forceinline__ void load_q(bf16x8 (&qf)[4], const bf16* Z, int rowbase, int qcol, int lane) {
    const int q = lane & 31, h = lane >> 5; const bf16* p = Z + (size_t)rm_row<RM>(rowbase, q) * IND + qcol + rm_col<RM>(q) + 8 * h;
#pragma unroll
    for (int ds = 0; ds < 4; ++ds) qf[ds] = *(const bf16x8*)(p + 16 * ds);
}
template <int RM> __device__ __forceinline__ void store_o(const bf16* Z, bf16* MIX, int rowbase, int gcol, int mcol, const LAS unsigned char* ost, int lane) {
#pragma unroll
    for (int i = 0; i < 4; ++i) { const int q = i * 8 + (lane >> 3), ch = lane & 7;
        if (RM == 2 && q >= 8) continue;
        const u32x4 ov = *(const LAS u32x4*)(ost + q * 144 + ch * 16);
        const int row = rm_row<RM>(rowbase, q), ca = rm_col<RM>(q);
        const u32x4 gv = *(const u32x4*)(Z + (size_t)row * IND + gcol + ca + 8 * ch);
        u32x4 w;
        w.x = pk2(bflo(gv.x) * bflo(ov.x), bfhi(gv.x) * bfhi(ov.x)); w.y = pk2(bflo(gv.y) * bflo(ov.y), bfhi(gv.y) * bfhi(ov.y));
        w.z = pk2(bflo(gv.z) * bflo(ov.z), bfhi(gv.z) * bfhi(ov.z)); w.w = pk2(bflo(gv.w) * bflo(ov.w), bfhi(gv.w) * bfhi(ov.w));
        *(u32x4*)(MIX + (size_t)row * D + mcol + ca + 8 * ch) = w; }
    LDS_WAIT(); asm volatile("" ::: "memory");
}

constexpr int AL_K = 0, AL_V = 49152, AL_OST = 98304;
constexpr int KCS_P = 256 * 16 + 16, VHS_P = 256 * 64 + 64;
constexpr int KCS_S = 160 * 16 + 16, VHS_S = 160 * 64 + 64, KS_S = 8 * KCS_S, VS_S = 2 * VHS_S;
static_assert(8 * KCS_P <= AL_V - AL_K && 2 * VHS_P <= AL_OST - AL_V && 2 * KS_S <= AL_V && 2 * VS_S <= AL_OST - AL_V && AL_OST + 8 * 4608 <= LDS_BYTES, "mixer LDS map");

__device__ __forceinline__ void put_k(LAS unsigned char* Kl, int kcs, int key, int c, u32x4 v) { *(LAS u32x4*)(Kl + c * kcs + key * 16) = v; }
__device__ __forceinline__ void put_v(LAS unsigned char* Vl, int vhs, int key, int c, u32x4 v) { *(LAS u32x4*)(Vl + (c >> 2) * vhs + key * 64 + (c & 3) * 16) = v; }
__device__ __forceinline__ u32x4 cvt8(f32x4 a, f32x4 b) { u32x4 w; w.x = pk2(a.x, a.y); w.y = pk2(a.z, a.w); w.z = pk2(b.x, b.y); w.w = pk2(b.z, b.w); return w; }

__device__ __forceinline__ void unit_swa_prompt(Ctx& F, int l, int unit) {
    const int i = unit & 63, kvh = (unit >> 6) & 1, b = unit >> 7;
    LAS unsigned char* Kl = F.lds + AL_K; LAS unsigned char* Vl = F.lds + AL_V;
    const int row0 = b * SEQ + 128 * (i - 1);
#pragma unroll
    for (int it = 0; it < 4; ++it) { const int id = F.tid + 512 * it, key = id >> 3, c = id & 7; u32x4 kv = {0u, 0u, 0u, 0u}, vv = {0u, 0u, 0u, 0u};
        if (i > 0 || key >= 128) { const bf16* zr = F.Z + (size_t)(row0 + key) * IND + kvh * 64 + 8 * c; kv = *(const u32x4*)(zr + ZC_K); vv = *(const u32x4*)(zr + ZC_V); }
        put_k(Kl, KCS_P, key, c, kv); put_v(Vl, VHS_P, key, c, vv); }
    if (i == 63) {
#pragma unroll
        for (int it = 0; it < 2; ++it) { const int id = F.tid + 512 * it, j = id >> 3, c = id & 7; const bf16* zr = F.Z + (size_t)(b * SEQ + SEQ - 128 + j) * IND + kvh * 64 + 8 * c;
            const u32x4 kv = *(const u32x4*)(zr + ZC_K), vv = *(const u32x4*)(zr + ZC_V); const size_t o = ((size_t)((l * 2 + b) * 128 + j)) * 128 + kvh * 64 + 8 * c;
            float* ok = F.out + O_WKP + o; float* ov = F.out + O_WVP + o;
            *(f32x4*)ok = (f32x4){bflo(kv.x), bfhi(kv.x), bflo(kv.y), bfhi(kv.y)}; *(f32x4*)(ok + 4) = (f32x4){bflo(kv.z), bfhi(kv.z), bflo(kv.w), bfhi(kv.w)};
            *(f32x4*)ov = (f32x4){bflo(vv.x), bfhi(vv.x), bflo(vv.y), bfhi(vv.y)}; *(f32x4*)(ov + 4) = (f32x4){bflo(vv.z), bfhi(vv.z), bflo(vv.w), bfhi(vv.w)}; }
    }
    __syncthreads();
    LAS unsigned char* ost = F.lds + AL_OST + F.wave * 4608;
#pragma unroll 1
    for (int tk = F.wave; tk < 16; tk += 8) { const int g = tk & 3, sb = tk >> 2, head = kvh * 4 + g, rowbase = b * SEQ + 128 * i + 32 * sb;
        bf16x8 qf[4]; load_q<0>(qf, F.Z, rowbase, ZC_Q + head * 64, F.lane);
        const float sink2 = F.sinks[l * 8 + head] * LOG2E;
        attn_core<5, 1>(qf, Kl + sb * 32 * 16, KCS_P, Vl + sb * 32 * 64, VHS_P, sink2, i == 0 ? 4 - sb : 0, ost, F.lane);
        store_o<0>(F.Z, F.MIX, rowbase, ZC_AG + head * 64, MC_B + head * 64, ost, F.lane); }
    __syncthreads();
}
__device__ __forceinline__ void unit_mem_prompt(Ctx& F, int l, int unit) {
    const int jb = unit & 31, mh = (unit >> 5) & 3, b = unit >> 7;
    LAS unsigned char* Kl = F.lds + AL_K; LAS unsigned char* Vl = F.lds + AL_V;
#pragma unroll
    for (int it = 0; it < 4; ++it) { const int id = F.tid + 512 * it, key = id >> 3, c = id & 7; const bf16* mr = F.MKV + ((size_t)(l * 512 + b * 256 + key)) * 512 + mh * 64 + 8 * c;
        put_k(Kl, KCS_P, key, c, *(const u32x4*)mr); put_v(Vl, VHS_P, key, c, *(const u32x4*)(mr + 256)); }
    __syncthreads();
    LAS unsigned char* ost = F.lds + AL_OST + F.wave * 4608;
    const int rowbase = b * SEQ + 256 * jb + 32 * F.wave;
    bf16x8 qf[4]; load_q<0>(qf, F.Z, rowbase, ZC_MQ + mh * 64, F.lane);
    attn_core<8, 0>(qf, Kl, KCS_P, Vl, VHS_P, -INFINITY, 0, ost, F.lane);
    store_o<0>(F.Z, F.MIX, rowbase, ZC_MG + mh * 64, MC_C + mh * 64, ost, F.lane);
    __syncthreads();
}
__device__ __forceinline__ void unit_swa_sample(Ctx& F, int l, int n) {
    LAS unsigned char* Kl = F.lds + AL_K; LAS unsigned char* Vl = F.lds + AL_V;
    const size_t cbase = ((size_t)(l * NB + n)) * 128 * 128;
#pragma unroll
    for (int it = 0; it < 4; ++it) { const int id = F.tid + 512 * it, c = id & 7, kvh = (id >> 3) & 1, j = id >> 4; const size_t off = cbase + (size_t)j * 128 + kvh * 64 + 8 * c;
        const f32x4 k0 = *(const f32x4*)(F.cwk + off), k1 = *(const f32x4*)(F.cwk + off + 4), v0 = *(const f32x4*)(F.cwv + off), v1 = *(const f32x4*)(F.cwv + off + 4);
        put_k(Kl + kvh * KS_S, KCS_S, j, c, cvt8(k0, k1)); put_v(Vl + kvh * VS_S, VHS_S, j, c, cvt8(v0, v1));
        if (j >= 8) { const size_t oo = off - 8 * 128; *(f32x4*)(F.out + O_WKS + oo) = k0; *(f32x4*)(F.out + O_WKS + oo + 4) = k1; *(f32x4*)(F.out + O_WVS + oo) = v0; *(f32x4*)(F.out + O_WVS + oo + 4) = v1; } }
    if (F.tid < 256) { const int isv = F.tid >> 7, id = F.tid & 127, c = id & 7, kvh = (id >> 3) & 1, t = id >> 4;
        const u32x4 w = *(const u32x4*)(F.Z + (size_t)(MP + n * TS + t) * IND + (isv ? ZC_V : ZC_K) + kvh * 64 + 8 * c);
        if (isv) put_v(Vl + kvh * VS_S, VHS_S, 128 + t, c, w); else put_k(Kl + kvh * KS_S, KCS_S, 128 + t, c, w);
        float* o = F.out + (isv ? O_WVS : O_WKS) + cbase + (size_t)(120 + t) * 128 + kvh * 64 + 8 * c;
        *(f32x4*)o = (f32x4){bflo(w.x), bfhi(w.x), bflo(w.y), bfhi(w.y)}; *(f32x4*)(o + 4) = (f32x4){bflo(w.z), bfhi(w.z), bflo(w.w), bfhi(w.w)}; }
    for (int id = F.tid; id < 24 * 2 * 8; id += 512) { const int c = id & 7, kvh = (id >> 3) & 1, j = 136 + (id >> 4); const u32x4 zz = {0u, 0u, 0u, 0u};
        put_k(Kl + kvh * KS_S, KCS_S, j, c, zz); put_v(Vl + kvh * VS_S, VHS_S, j, c, zz); }
    __syncthreads();
    if (F.wave < 2) { const int kvh = F.wave; LAS unsigned char* ost = F.lds + AL_OST + F.wave * 4608; const int rowbase = MP + n * TS;
        bf16x8 qf[4]; load_q<1>(qf, F.Z, rowbase, ZC_Q + kvh * 256, F.lane);
        const float sink2 = F.sinks[l * 8 + kvh * 4 + ((F.lane & 31) >> 3)] * LOG2E;
        attn_core<5, 2>(qf, Kl + kvh * KS_S, KCS_S, Vl + kvh * VS_S, VHS_S, sink2, 0, ost, F.lane);
        store_o<1>(F.Z, F.MIX, rowbase, ZC_AG + kvh * 256, MC_B + kvh * 256, ost, F.lane); }
    __syncthreads();
}
__device__ __forceinline__ void unit_mem_sample(Ctx& F, int l, int unit) {
    const int mh = unit & 3, n = unit >> 2;
    LAS unsigned char* Kl = F.lds + AL_K; LAS unsigned char* Vl = F.lds + AL_V;
    const size_t cbase = ((size_t)(l * NB + n)) * 256 * 256 + mh * 64;
#pragma unroll
    for (int it = 0; it < 4; ++it) { const int id = F.tid + 512 * it, key = id >> 3, c = id & 7; const size_t off = cbase + (size_t)key * 256 + 8 * c;
        const f32x4 k0 = *(const f32x4*)(F.cmk + off), k1 = *(const f32x4*)(F.cmk + off + 4), v0 = *(const f32x4*)(F.cmv + off), v1 = *(const f32x4*)(F.cmv + off + 4);
        put_k(Kl, KCS_P, key, c, cvt8(k0, k1)); put_v(Vl, VHS_P, key, c, cvt8(v0, v1)); }
    __syncthreads();
    if (F.wave == 0) { LAS unsigned char* ost = F.lds + AL_OST; const int rowbase = MP + n * TS;
        bf16x8 qf[4]; load_q<2>(qf, F.Z, rowbase, ZC_MQ + mh * 64, F.lane);
        attn_core<8, 0>(qf, Kl, KCS_P, Vl, VHS_P, -INFINITY, 0, ost, F.lane);
        store_o<2>(F.Z, F.MIX, rowbase, ZC_MG + mh * 64, MC_C + mh * 64, ost, F.lane); }
    __syncthreads();
}
__device__ __forceinline__ void conv_u(const bf16* zr, int ch, float (&u)[8]) {
    const u32x4 a = *(const u32x4*)(zr + ZC_CC + ch), b = *(const u32x4*)(zr + ZC_CH + ch);
    u[0] = bflo(a.x) * bflo(b.x); u[1] = bfhi(a.x) * bfhi(b.x); u[2] = bflo(a.y) * bflo(b.y); u[3] = bfhi(a.y) * bfhi(b.y);
    u[4] = bflo(a.z) * bflo(b.z); u[5] = bfhi(a.z) * bfhi(b.z); u[6] = bflo(a.w) * bflo(b.w); u[7] = bfhi(a.w) * bfhi(b.w);
}
__device__ __forceinline__ void conv_items(Ctx& F, int l) {
    const int gt = F.bid * 512 + F.tid, NT = F.G * 512;
    const float* cw = F.conv_w + l * 3 * 256;
#pragma unroll 1
    for (int it = gt; it < M * 32; it += NT) { const int r = it >> 5, ch = (it & 31) * 8; const bf16* zr = F.Z + (size_t)r * IND;
        float u0[8], u1[8], u2[8];
        conv_u(zr, ch, u0);
        int t; const float* st = nullptr;
        if (r < MP) t = r & (SEQ - 1); else { const int s = r - MP; t = s & 7; st = F.sconv + ((size_t)(l * NB + (s >> 3))) * 512 + ch; }
        if (t >= 1) conv_u(zr - IND, ch, u1); else {
#pragma unroll
            for (int e = 0; e < 8; ++e) u1[e] = st ? st[256 + e] : 0.f; }
        if (t >= 2) conv_u(zr - 2 * IND, ch, u2); else {
#pragma unroll
            for (int e = 0; e < 8; ++e) u2[e] = st ? st[t * 256 + e] : 0.f; }
        const u32x4 cb = *(const u32x4*)(zr + ZC_CB + ch), gs = *(const u32x4*)(zr + ZC_CG + ch);
        const float cbf[8] = {bflo(cb.x), bfhi(cb.x), bflo(cb.y), bfhi(cb.y), bflo(cb.z), bfhi(cb.z), bflo(cb.w), bfhi(cb.w)};
        const float gsf[8] = {bflo(gs.x), bfhi(gs.x), bflo(gs.y), bfhi(gs.y), bflo(gs.z), bfhi(gs.z), bflo(gs.w), bfhi(gs.w)};
        float o[8];
#pragma unroll
        for (int e = 0; e < 8; ++e) { const float cv = cw[ch + e] * u2[e] + cw[256 + ch + e] * u1[e] + cw[512 + ch + e] * u0[e]; o[e] = gsf[e] * cbf[e] * cv; }
        u32x4 w; w.x = pk2(o[0], o[1]); w.y = pk2(o[2], o[3]); w.z = pk2(o[4], o[5]); w.w = pk2(o[6], o[7]);
        *(u32x4*)(F.MIX + (size_t)r * D + MC_A + ch) = w;
        float* so = nullptr;
        if (r < MP) { if (t >= SEQ - 2) so = F.out + O_CVP + ((size_t)((l * 2 + (r >> 13)) * 2 + (t - (SEQ - 2)))) * 256 + ch; }
        else { if (t >= TS - 2) so = F.out + O_CVS + ((size_t)((l * NB + ((r - MP) >> 3)) * 2 + (t - (TS - 2)))) * 256 + ch; }
        if (so) { *(f32x4*)so = (f32x4){u0[0], u0[1], u0[2], u0[3]}; *(f32x4*)(so + 4) = (f32x4){u0[4], u0[5], u0[6], u0[7]}; }
    }
}
__device__ __forceinline__ void mix_phase(Ctx& F, int l) {
    for (int u = F.bid; u < 256; u += F.G) unit_swa_prompt(F, l, u);
    for (int u = F.bid; u < 256; u += F.G) unit_mem_prompt(F, l, u);
    for (int u = F.bid; u < NB; u += F.G) unit_swa_sample(F, l, u);
    for (int u = F.bid; u < NB * 4; u += F.G) unit_mem_sample(F, l, u);
    conv_items(F, l);
}
__device__ __forceinline__ void norm_phase(Ctx& F, int l) {
    const int gw = F.bid * NWAVES + F.wave, NGW = F.G * NWAVES;
    const f32x4* gp = (const f32x4*)(F.npost + l * D) + F.lane;
    f32x4 g[4];
#pragma unroll
    for (int j = 0; j < 4; ++j) g[j] = gp[64 * j];
    for (int m = gw; m < M; m += NGW) {
        const float* xin = (l == 0) ? (m < MP ? F.x_prompt + (size_t)m * D : F.x_sample + (size_t)(m - MP) * D) : F.out + O_X + (size_t)m * D;
        const f32x4* yr = (const f32x4*)(F.Y + (size_t)m * D) + F.lane; const f32x4* xr = (const f32x4*)xin + F.lane;
        f32x4 y[4], x[4]; float s = 0.f;
#pragma unroll
        for (int j = 0; j < 4; ++j) { y[j] = yr[64 * j]; x[j] = xr[64 * j]; s += (y[j].x * y[j].x + y[j].y * y[j].y) + (y[j].z * y[j].z + y[j].w * y[j].w); }
        const float r = 1.0f / sqrtf(wave_sum(s) * (1.0f / D) + RMS_EPS); float s2 = 0.f;
        f32x4* xo = (f32x4*)(F.out + O_X + (size_t)m * D) + F.lane; u32x2* o8 = (u32x2*)(F.XB + (size_t)m * D) + F.lane;
#pragma unroll
        for (int j = 0; j < 4; ++j) { x[j] = x[j] + (y[j] * r) * g[j]; xo[64 * j] = x[j]; s2 += (x[j].x * x[j].x + x[j].y * x[j].y) + (x[j].z * x[j].z + x[j].w * x[j].w);
            u32x2 w; w.x = pk2(x[j].x, x[j].y); w.y = pk2(x[j].z, x[j].w); o8[64 * j] = w; }
        s2 = wave_sum(s2);
        if (F.lane == 0) F.RS[m] = 1.0f / sqrtf(s2 * (1.0f / D) + RMS_EPS);
    }
}

struct Args { const float* in[16]; float* out; unsigned char* ws; };
__global__ void __launch_bounds__(NWAVES * 64, 2) hymba_fwd(Args args) {
    extern __shared__ __attribute__((aligned(16))) unsigned char lds[];
    cg::grid_group grid = cg::this_grid();
    Ctx F;
    F.lds = (LAS unsigned char*)lds; F.tid = threadIdx.x; F.lane = F.tid & 63; F.wave = __builtin_amdgcn_readfirstlane(F.tid >> 6); F.G = gridDim.x; F.bid = blockIdx.x;
    F.x_prompt = args.in[0]; F.x_sample = args.in[1]; F.mem_prompt = args.in[2]; F.cwk = args.in[3]; F.cwv = args.in[4]; F.sconv = args.in[5]; F.cmk = args.in[6]; F.cmv = args.in[7];
    F.npre = args.in[8]; F.npost = args.in[9]; F.nmem = args.in[10]; F.w_in = args.in[11]; F.conv_w = args.in[12]; F.sinks = args.in[13]; F.w_mem = args.in[14]; F.w_out = args.in[15];
    F.out = args.out; F.ws = args.ws;
    unsigned char* ws = args.ws;
    F.W1T = (bf16*)(ws + WS_W1T); F.W2T = (bf16*)(ws + WS_W2T); F.WMT = (bf16*)(ws + WS_WMT); F.MEMB = (bf16*)(ws + WS_MEMB); F.MKV = (bf16*)(ws + WS_MKV);
    F.XB = (bf16*)(ws + WS_XB); F.MIX = (bf16*)(ws + WS_MIX); F.Z = (bf16*)(ws + WS_Z); F.RS = (float*)(ws + WS_RS); F.RSM = (float*)(ws + WS_RSM); F.Y = (float*)(ws + WS_Y);

#define RELANE() do { int t_ = threadIdx.x; asm volatile("" : "+v"(t_)); F.tid = t_; F.lane = t_ & 63; } while (0)
    p0_prologue(F);
    grid.sync();
#pragma unroll 1
    for (int l = 0; l < NL; ++l) {
        {
            pg8::Gemm g{F.XB, F.W1T + (size_t)l * IND * D, M, IND, D}; pg8::StaticOrder S; S.init(M, IND, F.G, F.bid);
            pg8::EpiZ E{F.Z, F.RS, IND};
            pg8::gemm_phase<pg8::EpiZ, pg8::StaticOrder, true, true>(F.lds, g, S, E);
            if (l == 0) {
                pg8::Gemm gm{F.MEMB, F.WMT, 512, NL * 512, D}; pg8::MkvOrder SM{F.bid - (F.G - 16)};
                pg8::EpiMKV EM{F.out + O_MKP, O_MVP - O_MKP, F.MKV, F.RSM};
                pg8::gemm_phase<pg8::EpiMKV, pg8::MkvOrder, true, true>(F.lds, gm, SM, EM);
            }
        }
        grid.sync();
        RELANE(); mix_phase(F, l);
        grid.sync();
        {
            pg8::Gemm g{F.MIX, F.W2T + (size_t)l * D * D, M, D, D}; pg8::StaticOrder S; S.init(M, D, F.G, F.bid);
            pg8::EpiY E{F.Y, D};
            pg8::gemm_phase<pg8::EpiY, pg8::StaticOrder, true, true>(F.lds, g, S, E);
        }
        grid.sync();
        RELANE(); norm_phase(F, l);
        if (l + 1 < NL) grid.sync();
    }
}

extern "C" void kernel_launch(void* const* d_in, const int* in_sizes, int n_in, void* d_out, int out_size, void* d_ws, size_t ws_size, hipStream_t stream) {
    static int grid = 0;
    if (grid == 0) {
        if (n_in != 16 || in_sizes[0] != MP * D || (size_t)out_size != O_END || ws_size < WS_END) {
            fprintf(stderr, "kernel_launch: unexpected shapes: n_in %d in0 %d out %d (want %zu) ws %zu (want >= %zu); nothing launched\n", n_in, n_in > 0 ? in_sizes[0] : -1, out_size, (size_t)O_END, ws_size, (size_t)WS_END); grid = -1; return; }
        int dev = 0, cus = 0, per_cu = 0;
        if (hipGetDevice(&dev) != hipSuccess || hipDeviceGetAttribute(&cus, hipDeviceAttributeMultiprocessorCount, dev) != hipSuccess) { grid = -1; return; }
        if (hipFuncSetAttribute((const void*)hymba_fwd, hipFuncAttributeMaxDynamicSharedMemorySize, LDS_BYTES) != hipSuccess) { fprintf(stderr, "kernel_launch: hipFuncSetAttribute failed\n"); grid = -1; return; }
        if (hipOccupancyMaxActiveBlocksPerMultiprocessor(&per_cu, (const void*)hymba_fwd, NWAVES * 64, LDS_BYTES) != hipSuccess || per_cu < 1) { fprintf(stderr, "kernel_launch: occupancy query says %d blocks per CU; nothing launched\n", per_cu); (void)hipGetLastError(); grid = -1; return; }
        grid = cus;
        fprintf(stderr, "kernel_launch: %d CUs, occupancy %d per CU, grid %d\n", cus, per_cu, grid);
    }
    if (grid < 0) return;
    Args a{};
    for (int i = 0; i < 16; ++i) a.in[i] = (const float*)d_in[i];
    a.out = (float*)d_out; a.ws = (unsigned char*)d_ws;
    void* args[] = {&a};
    const hipError_t e = hipLaunchCooperativeKernel((const void*)hymba_fwd, dim3(grid), dim3(NWAVES * 64), args, LDS_BYTES, stream);
    if (e != hipSuccess) fprintf(stderr, "kernel_launch: cooperative launch failed: %s (grid %d)\n", hipGetErrorString(e), grid);
}
```

```cpp
#include <hip/hip_runtime.h>
#include <hip/hip_cooperative_groups.h>
#include <cstdio>
#include <cstdint>
namespace cg = cooperative_groups;
namespace pg8 {
#define PG8_LAS __attribute__((address_space(3)))
typedef unsigned short bf16_t;
typedef short bf16x8 __attribute__((ext_vector_type(8)));
typedef float f32x4 __attribute__((ext_vector_type(4)));
typedef unsigned u32x4 __attribute__((ext_vector_type(4)));
constexpr int BM = 256, BK = 64, HALF = 128, HTB = HALF * BK * 2  , STAGE_BYTES = 8 * HTB, NXCD = 8, WGM = 8;

__host__ __device__ __forceinline__ int lds_byte(int r, int c) { const int st = (r >> 4) * 2 + (c >> 5), rr = r & 15, cc = c & 31, ob = rr * 64 + cc * 2; return st * 1024 + (ob ^ (((ob >> 9) & 1) << 5)); }
__host__ __device__ __forceinline__ void stage_rc(int b, int& R, int& C) { const int st = b / 1024, sb = b % 1024, swz = sb ^ (((sb >> 9) & 1) << 5); R = (st >> 1) * 16 + swz / 64; C = (st & 1) * 32 + (swz % 64) / 2; }
__host__ __device__ __forceinline__ int perm32(int rho) { const int n = rho >> 4, i = rho & 15; return 8 * (i >> 2) + 4 * n + (i & 3); }

struct Unit { int pm, pn; };
struct Gemm { const bf16_t* A; const bf16_t* Bt; int M, N, K; };

struct StaticOrder {
    int nM, nN, nwg, G, c;
    __host__ __device__ void init(int M, int N, int G_, int c_) { nM = M / BM; nN = N / BM; nwg = nM * nN; G = G_; c = c_; }
    __host__ __device__ bool next(int i, Unit& u) const {
        const long L = (long)i * G + c; if (L >= nwg) return false;
        int wgid = (int)L; { const int q = nwg / NXCD, r = nwg % NXCD, xcd = wgid % NXCD, off = wgid / NXCD; wgid = (xcd < r ? xcd * (q + 1) : r * (q + 1) + (xcd - r) * q) + off; }
        const int nig = WGM * nN, gid = wgid / nig, fm = gid * WGM, gsz = (nM - fm) < WGM ? (nM - fm) : WGM;
        u.pm = fm + ((wgid % nig) % gsz); u.pn = (wgid % nig) / gsz; return true;
    }
    __device__ __forceinline__ void a_ready(const Unit&) const {}
    __device__ __forceinline__ void done(const Unit&) const {}
};

__device__ __forceinline__ unsigned cvt_pk_bf16(float lo, float hi) { unsigned r; asm volatile("v_cvt_pk_bf16_f32 %0, %1, %2" : "=v"(r) : "v"(lo), "v"(hi)); return r; }
typedef float f32x2 __attribute__((ext_vector_type(2)));
typedef unsigned u32x2 __attribute__((ext_vector_type(2)));
__device__ __forceinline__ float silu_f(float v) { return v * __builtin_amdgcn_rcpf(1.0f + __builtin_amdgcn_exp2f(-1.4426950408889634f * v)); }
struct EpiZ {
    static constexpr bool PERM = true, AFTER_DRAIN = false;
    bf16_t* Z; const float* rs; int ldc;
    __device__ __forceinline__ void operator()(const f32x4 (&acc)[2][2][4][2], const Unit& u, int wr, int wc, int fr, int fq) const {
        const int row0 = u.pm * BM + wr * 64 + fr, col0 = u.pn * BM + wc * 32 + 8 * fq;
        const bool gate = (u.pn == 3) || (u.pn == 7) || (u.pn == 8) || (u.pn == 10);
#pragma unroll
        for (int ai = 0; ai < 2; ++ai)
#pragma unroll
            for (int m = 0; m < 4; ++m) { const int row = row0 + ai * HALF + m * 16; const float sc = rs[row]; bf16_t* rowp = Z + (size_t)row * ldc + col0;
#pragma unroll
                for (int bj = 0; bj < 2; ++bj) { f32x4 v0 = acc[ai][bj][m][0] * sc, v1 = acc[ai][bj][m][1] * sc;
                    if (gate) {
#pragma unroll
                        for (int e = 0; e < 4; ++e) { v0[e] = silu_f(v0[e]); v1[e] = silu_f(v1[e]); } }
                    u32x4 w; w.x = cvt_pk_bf16(v0[0], v0[1]); w.y = cvt_pk_bf16(v0[2], v0[3]); w.z = cvt_pk_bf16(v1[0], v1[1]); w.w = cvt_pk_bf16(v1[2], v1[3]);
                    *(u32x4*)(rowp + bj * HALF) = w; } }
    }
};
struct EpiMKV {
    static constexpr bool PERM = false, AFTER_DRAIN = false;
    float* outK; size_t kv_stride; bf16_t* MKV; const float* rsm;
    __device__ __forceinline__ void operator()(const f32x4 (&acc)[2][2][4][2], const Unit& u, int wr, int wc, int fr, int fq) const {
        const int row0 = u.pm * BM + wr * 64 + fr, col0 = u.pn * BM + wc * 32 + 4 * fq;
#pragma unroll
        for (int ai = 0; ai < 2; ++ai)
#pragma unroll
            for (int m = 0; m < 4; ++m) { const int row = row0 + ai * HALF + m * 16; const float sc = rsm[row]; const int b = row >> 8, mm = row & 255;
#pragma unroll
                for (int bj = 0; bj < 2; ++bj)
#pragma unroll
                    for (int n = 0; n < 2; ++n) { const int c = col0 + bj * HALF + n * 16, l = c >> 9, cc = c & 511; const f32x4 v = acc[ai][bj][m][n] * sc;
                        float* o = outK + (size_t)(cc >> 8) * kv_stride + ((size_t)((l * 2 + b) * 256 + mm)) * 256 + (cc & 255); *(f32x4*)o = v;
                        u32x2 w; w.x = cvt_pk_bf16(v[0], v[1]); w.y = cvt_pk_bf16(v[2], v[3]); *(u32x2*)(MKV + ((size_t)(l * 512 + row)) * 512 + cc) = w; } }
    }
};
struct EpiY {
    static constexpr bool PERM = false, AFTER_DRAIN = false;
    float* Y; int ldc;
    __device__ __forceinline__ void operator()(const f32x4 (&acc)[2][2][4][2], const Unit& u, int wr, int wc, int fr, int fq) const {
        const int row0 = u.pm * BM + wr * 64 + fr, col0 = u.pn * BM + wc * 32 + 4 * fq;
#pragma unroll
        for (int ai = 0; ai < 2; ++ai)
#pragma unroll
            for (int m = 0; m < 4; ++m) { float* rowp = Y + (size_t)(row0 + ai * HALF + m * 16) * ldc + col0;
#pragma unroll
                for (int bj = 0; bj < 2; ++bj)
#pragma unroll
                    for (int n = 0; n < 2; ++n) *(f32x4*)(rowp + bj * HALF + n * 16) = acc[ai][bj][m][n]; }
    }
};
struct MkvOrder {
    int c;
    __host__ __device__ bool next(int i, Unit& u) const { if (i > 0 || c < 0) return false; const int k = c; u.pm = k & 1; u.pn = k >> 1; return true; }
    __device__ __forceinline__ void a_ready(const Unit&) const {}
    __device__ __forceinline__ void done(const Unit&) const {}
};
template <class Epi, class Sched, bool ALIGN_EPI = false, bool SP2 = false>
__device__ __forceinline__ void gemm_phase(PG8_LAS unsigned char* lds, const Gemm g, const Sched& S, const Epi& E) {
    int tid_ = threadIdx.x; asm volatile("" : "+v"(tid_));
    const int tid = tid_, wid = __builtin_amdgcn_readfirstlane(tid >> 6), lane = tid & 63, wr = wid >> 2, wc = wid & 3, fr = lane & 15, fq = lane >> 4;
    const int K = g.K, nt = K / BK;
    unsigned voffA[2], voffB[2];
#pragma unroll
    for (int i = 0; i < 2; ++i) { int R, C; stage_rc(tid * 16 + i * 8192, R, C); const int Rb = Epi::PERM ? ((R & ~31) + perm32(R & 31)) : R;
        voffA[i] = (unsigned)(R * K + C) * 2u; voffB[i] = (unsigned)(Rb * K + C) * 2u; }
    const size_t kstep = (size_t)(BK * 2);
    const size_t hstep = (size_t)HALF * K * 2;
    const size_t tstep = 2 * hstep;
    const unsigned ldsw = (unsigned)wid * 1024u;
    const int aoff = lds_byte(wr * 64 + fr, fq * 8), boff = lds_byte(wc * 32 + fr, fq * 8);
#define PG8_SA(b, h) (((b) * 2 + (h)) * HTB)
#define PG8_SB(b, h) ((4 + (b) * 2 + (h)) * HTB)
#define PG8_STAGE(bufoff, gbase, voff) do { _Pragma("unroll") for (int _i = 0; _i < 2; ++_i) \
        __builtin_amdgcn_global_load_lds((const unsigned*)((const char*)(gbase) + (voff)[_i]), (PG8_LAS unsigned*)(lds + (bufoff) + ldsw + _i * 8192), 16, 0, 0); } while (0)
#define PG8_LDA(dst, b, h) do { _Pragma("unroll") for (int m = 0; m < 4; ++m) _Pragma("unroll") for (int k = 0; k < 2; ++k) dst[m][k] = *(const PG8_LAS bf16x8*)(lds + PG8_SA(b, h) + aoff + m * 2048 + k * 1024); } while (0)
#define PG8_LDB(dst, b, h) do { _Pragma("unroll") for (int n = 0; n < 2; ++n) _Pragma("unroll") for (int k = 0; k < 2; ++k) dst[n][k] = *(const PG8_LAS bf16x8*)(lds + PG8_SB(b, h) + boff + n * 2048 + k * 1024); } while (0)
#define PG8_MMA(ai, bj, At, Bt) do { __builtin_amdgcn_s_setprio(1); _Pragma("unroll") for (int m = 0; m < 4; ++m) _Pragma("unroll") for (int n = 0; n < 2; ++n) _Pragma("unroll") for (int k = 0; k < 2; ++k) \
        acc[ai][bj][m][n] = __builtin_amdgcn_mfma_f32_16x16x32_bf16(Bt[n][k], At[m][k], acc[ai][bj][m][n], 0, 0, 0); __builtin_amdgcn_s_setprio(0); } while (0)
#define PG8_WAIT_V(n) asm volatile("s_waitcnt vmcnt(" #n ")" ::: "memory")
#define PG8_WAIT_L(n) asm volatile("s_waitcnt lgkmcnt(" #n ")" ::: "memory")
#define PG8_BAR __builtin_amdgcn_s_barrier()
#define PG8_SCHED __builtin_amdgcn_sched_barrier(0)
    Unit cur, nxt; int ui = 0;
    if (!S.next(0, cur)) return;
    f32x4 acc[2][2][4][2];
#pragma unroll
    for (int a = 0; a < 2; ++a)
#pragma unroll
        for (int b = 0; b < 2; ++b)
#pragma unroll
            for (int m = 0; m < 4; ++m)
#pragma unroll
                for (int n = 0; n < 2; ++n) acc[a][b][m][n] = (f32x4){0.f, 0.f, 0.f, 0.f};
    bf16x8 At[4][2], B0[2][2], B1[2][2];
    const char* cA = (const char*)g.A + (size_t)cur.pm * tstep; const char* cB = (const char*)g.Bt + (size_t)cur.pn * tstep;
    S.a_ready(cur);
    if constexpr (SP2) {
        PG8_STAGE(PG8_SB(0, 0), cB, voffB); PG8_STAGE(PG8_SB(0, 1), cB + hstep, voffB); PG8_STAGE(PG8_SA(0, 0), cA, voffA); PG8_STAGE(PG8_SA(0, 1), cA + hstep, voffA);
        if (wr == 1) PG8_BAR;
        PG8_WAIT_V(2); PG8_BAR;
        PG8_STAGE(PG8_SB(1, 0), cB + kstep, voffB); PG8_STAGE(PG8_SA(1, 0), cA + kstep, voffA); PG8_STAGE(PG8_SB(1, 1), cB + hstep + kstep, voffB);
        PG8_WAIT_V(6); PG8_BAR;
    } else {
        PG8_STAGE(PG8_SB(0, 0), cB, voffB); PG8_STAGE(PG8_SA(0, 0), cA, voffA); PG8_STAGE(PG8_SB(0, 1), cB + hstep, voffB); PG8_STAGE(PG8_SA(0, 1), cA + hstep, voffA);
        if (wr == 1) PG8_BAR;
        PG8_WAIT_V(4); PG8_BAR;
        PG8_STAGE(PG8_SB(1, 0), cB + kstep, voffB); PG8_STAGE(PG8_SA(1, 0), cA + kstep, voffA); PG8_STAGE(PG8_SB(1, 1), cB + hstep + kstep, voffB);
        PG8_WAIT_V(6); PG8_BAR;
    }
    for (;;) {
        const bool has_next = S.next(ui + 1, nxt);
        const char* nA = has_next ? (const char*)g.A + (size_t)nxt.pm * tstep : cA; const char* nB = has_next ? (const char*)g.Bt + (size_t)nxt.pn * tstep : cB;
        for (int t = 0; t < nt; t += 2) {
            const bool last = (t == nt - 2);
            const char* a1 = cA + (size_t)(t + 1) * kstep;
            const char* a2 = last ? nA : cA + (size_t)(t + 2) * kstep; const char* b2 = last ? nB : cB + (size_t)(t + 2) * kstep;
            const char* a3 = a2 + kstep; const char* b3 = b2 + kstep;
            if (last && has_next) S.a_ready(nxt);
            if constexpr (SP2) {
            PG8_LDB(B0, 0, 0); PG8_LDB(B1, 0, 1); PG8_SCHED; PG8_LDA(At, 0, 0); PG8_STAGE(PG8_SA(1, 1), a1 + hstep, voffA);
            PG8_WAIT_V(8); PG8_WAIT_L(0); PG8_BAR; PG8_MMA(0, 0, At, B0); PG8_MMA(0, 1, At, B1); PG8_BAR; PG8_SCHED;
            PG8_LDA(At, 0, 1); PG8_STAGE(PG8_SB(0, 0), b2, voffB); PG8_STAGE(PG8_SB(0, 1), b2 + hstep, voffB); PG8_STAGE(PG8_SA(0, 0), a2, voffA);
            PG8_WAIT_V(8); PG8_WAIT_L(0); PG8_BAR; PG8_MMA(1, 0, At, B0); PG8_MMA(1, 1, At, B1); PG8_BAR; PG8_SCHED;
            PG8_LDB(B0, 1, 0); PG8_LDB(B1, 1, 1); PG8_SCHED; PG8_LDA(At, 1, 0); PG8_STAGE(PG8_SA(0, 1), a2 + hstep, voffA);
            PG8_WAIT_V(8); PG8_WAIT_L(0); PG8_BAR; PG8_MMA(0, 0, At, B0); PG8_MMA(0, 1, At, B1); PG8_BAR; PG8_SCHED;
            PG8_LDA(At, 1, 1); PG8_STAGE(PG8_SB(1, 0), b3, voffB); PG8_STAGE(PG8_SB(1, 1), b3 + hstep, voffB); PG8_STAGE(PG8_SA(1, 0), a3, voffA);
            PG8_WAIT_V(8); PG8_WAIT_L(0); PG8_BAR; PG8_MMA(1, 0, At, B0); PG8_MMA(1, 1, At, B1); PG8_BAR; PG8_SCHED;
            } else {
            PG8_LDB(B0, 0, 0); PG8_SCHED; PG8_LDA(At, 0, 0); PG8_STAGE(PG8_SA(1, 1), a1 + hstep, voffA);
            PG8_WAIT_L(8); PG8_BAR; PG8_WAIT_L(0); PG8_MMA(0, 0, At, B0); PG8_BAR; PG8_SCHED;
            PG8_LDB(B1, 0, 1); PG8_STAGE(PG8_SB(0, 0), b2, voffB);
            PG8_BAR; PG8_WAIT_L(0); PG8_MMA(0, 1, At, B1); PG8_BAR;
            PG8_LDA(At, 0, 1); PG8_STAGE(PG8_SA(0, 0), a2, voffA);
            PG8_BAR; PG8_WAIT_L(0); PG8_MMA(1, 0, At, B0); PG8_BAR; PG8_SCHED;
            PG8_STAGE(PG8_SB(0, 1), b2 + hstep, voffB);
            PG8_WAIT_V(6); PG8_BAR; PG8_MMA(1, 1, At, B1); PG8_BAR;
            PG8_LDB(B0, 1, 0); PG8_SCHED; PG8_LDA(At, 1, 0); PG8_STAGE(PG8_SA(0, 1), a2 + hstep, voffA);
            PG8_WAIT_L(8); PG8_BAR; PG8_WAIT_L(0); PG8_MMA(0, 0, At, B0); PG8_BAR; PG8_SCHED;
            PG8_LDB(B1, 1, 1); PG8_STAGE(PG8_SB(1, 0), b3, voffB);
            PG8_BAR; PG8_WAIT_L(0); PG8_MMA(0, 1, At, B1); PG8_BAR;
            PG8_LDA(At, 1, 1); PG8_STAGE(PG8_SA(1, 0), a3, voffA);
            PG8_BAR; PG8_WAIT_L(0); PG8_MMA(1, 0, At, B0); PG8_BAR; PG8_SCHED;
            PG8_STAGE(PG8_SB(1, 1), b3 + hstep, voffB);
            PG8_WAIT_V(6); PG8_BAR; PG8_MMA(1, 1, At, B1); PG8_BAR;
            }
        }
        if constexpr (ALIGN_EPI) { if (wr == 0) PG8_BAR; }
        if constexpr (!Epi::AFTER_DRAIN) { E(acc, cur, wr, wc, fr, fq); S.done(cur); }
        if (!has_next) break;
#pragma unroll
        for (int a = 0; a < 2; ++a)
#pragma unroll
            for (int b = 0; b < 2; ++b)
#pragma unroll
                for (int m = 0; m < 4; ++m)
#pragma unroll
                    for (int n = 0; n < 2; ++n) acc[a][b][m][n] = (f32x4){0.f, 0.f, 0.f, 0.f};
        cur = nxt; cA = nA; cB = nB; ++ui;
        if constexpr (ALIGN_EPI) { if (wr == 1) PG8_BAR; }
    }
    PG8_WAIT_V(0);
    if constexpr (!ALIGN_EPI) { if (wr == 0) PG8_BAR; }
    PG8_BAR;
    if constexpr (Epi::AFTER_DRAIN) { E.fused(acc, cur, wr, wc, fr, fq, lds, wid, lane); S.done(cur); }
#undef PG8_SA
#undef PG8_SB
#undef PG8_STAGE
#undef PG8_LDA
#undef PG8_LDB
#undef PG8_MMA
#undef PG8_WAIT_V
#undef PG8_WAIT_L
#undef PG8_BAR
#undef PG8_SCHED
}
}

constexpr int D = 1024, SEQ = 8192, MP = 2 * SEQ, NB = 128, TS = 8, MS = NB * TS, M = MP + MS, NL = 4, IND = 2816, NMEM = 256;
constexpr int ZC_CB = 0, ZC_CC = 256, ZC_CH = 512, ZC_CG = 768, ZC_Q = 1024, ZC_K = 1536, ZC_V = 1664, ZC_AG = 1792, ZC_MQ = 2304, ZC_MG = 2560;
constexpr int MC_A = 0, MC_B = 256, MC_C = 768;
constexpr float RMS_EPS = 1e-6f;
constexpr float LOG2E = 1.4426950408889634f;
constexpr size_t MiB = 1u << 20;
constexpr size_t WS_W1T = 2 * MiB, WS_W2T = 24 * MiB, WS_WMT = 32 * MiB, WS_MEMB = 36 * MiB, WS_RS = 37 * MiB, WS_RSM = WS_RS + 512 * 1024, WS_MKV = 38 * MiB,
                 WS_XB = 40 * MiB, WS_MIX = 74 * MiB, WS_Z = 108 * MiB, WS_Y = 204 * MiB, WS_END = 272 * MiB;
static_assert(WS_W1T + (size_t)NL * IND * D * 2 <= WS_W2T && WS_XB + (size_t)M * D * 2 <= WS_MIX && WS_MIX + (size_t)M * D * 2 <= WS_Z && WS_Z + (size_t)M * IND * 2 <= WS_Y && WS_Y + (size_t)M * D * 4 <= WS_END, "ws map");
constexpr size_t O_X = 0, O_WKP = (size_t)M * D, O_WVP = O_WKP + 131072, O_CVP = O_WVP + 131072, O_MKP = O_CVP + 4096, O_MVP = O_MKP + 524288,
                 O_WKS = O_MVP + 524288, O_WVS = O_WKS + 8388608, O_CVS = O_WVS + 8388608, O_END = O_CVS + 262144;
constexpr int LDS_BYTES = 147456, LDS_MISC = 147456 - 256;
constexpr size_t WS_CTL = 0, CTL_ZERO_BYTES = 65536;
constexpr int NWAVES = 8;

#define LAS __attribute__((address_space(3)))
typedef unsigned short bf16;
typedef short bf16x8 __attribute__((ext_vector_type(8)));
typedef short s16x4 __attribute__((ext_vector_type(4)));
typedef short v4i16_t __attribute__((ext_vector_type(4)));
typedef float f32x4 __attribute__((ext_vector_type(4)));
typedef float f32x16 __attribute__((ext_vector_type(16)));
typedef unsigned u32x4 __attribute__((ext_vector_type(4)));
typedef unsigned u32x2 __attribute__((ext_vector_type(2)));
#define LDS_WAIT() asm volatile("s_waitcnt lgkmcnt(0)" ::: "memory")

__device__ __forceinline__ unsigned pk2(float lo, float hi) { typedef float f2_t __attribute__((ext_vector_type(2))); typedef __bf16 b2_t __attribute__((ext_vector_type(2)));
    f2_t v = {lo, hi}; b2_t b = __builtin_convertvector(v, b2_t); return __builtin_bit_cast(unsigned, b); }
__device__ __forceinline__ float bflo(unsigned w) { return __uint_as_float(w << 16); }
__device__ __forceinline__ float bfhi(unsigned w) { return __uint_as_float(w & 0xffff0000u); }
__device__ __forceinline__ float wave_sum(float v) {
#pragma unroll
    for (int o = 1; o < 64; o <<= 1) v += __shfl_xor(v, o);
    return v;
}
__device__ __forceinline__ int crow(int r, int hi) { return (r & 3) + 8 * (r >> 2) + 4 * hi; }
__device__ __forceinline__ s16x4 vtr(const LAS unsigned char* p) { return __builtin_bit_cast(s16x4, __builtin_amdgcn_ds_read_tr16_b64_v4i16((LAS v4i16_t*)p)); }

#define RLX_AGENT __ATOMIC_RELAXED, __HIP_MEMORY_SCOPE_AGENT
#define XB_TMO      128
#define XB_XCNT(j)  (256  + 64 * (j))
#define XB_XSUB(j)  (1280 + 64 * (j))
#define XB_XGEN(j)  (2304 + 64 * (j))
#define XB_TOP      3328
#define XB_TOPGEN   3392
#define XCD_BAR_WORDS 3456
#define XB_SPIN_CAP (1u << 18)

__device__ __forceinline__ unsigned xb_ld(unsigned* p)              { return __hip_atomic_load(p, __ATOMIC_RELAXED, __HIP_MEMORY_SCOPE_AGENT); }
__device__ __forceinline__ unsigned xb_add(unsigned* p, unsigned v) { return __hip_atomic_fetch_add(p, v, __ATOMIC_RELAXED, __HIP_MEMORY_SCOPE_AGENT); }
__device__ __forceinline__ unsigned xb_xcc_id() { return (unsigned)__builtin_amdgcn_s_getreg((3 << 11) | 20) & 0xFu; }
#define XB_SPIN(cond, bar) do { unsigned _sp = 0; while (cond) { __builtin_amdgcn_s_sleep(1); \
    if ((++_sp & 255u) == 0u) { if (xb_ld(&(bar)[XB_TMO])) break; if (_sp > XB_SPIN_CAP) { atomicAdd(&(bar)[XB_TMO], 1u); break; } } } } while (0)

struct XcdBarrier {
    unsigned* bar; unsigned x;
    volatile LAS unsigned* st;
};

__device__ __forceinline__ XcdBarrier xcd_barrier_post(unsigned* bar, volatile LAS unsigned* st) {
    XcdBarrier b; b.bar = bar; b.x = xb_xcc_id(); b.st = st;
    if (threadIdx.x == 0) (void)xb_add(&bar[XB_XCNT(b.x)], 1u);
    return b;
}
__device__ __forceinline__ void xcd_barrier_complete(unsigned* bar, unsigned x, unsigned& nloc, unsigned& nx) {
    const unsigned G = gridDim.x * gridDim.y * gridDim.z;
    unsigned sum, cnt, mine, sp = 0u;
    for (;;) {
        sum = 0u; cnt = 0u; mine = 0u;
#pragma unroll
        for (unsigned j = 0; j < 16; ++j) { const unsigned c = xb_ld(&bar[XB_XCNT(j)]); sum += c; cnt += (c > 0u) ? 1u : 0u; mine = (j == x) ? c : mine; }
        if (sum == G) break;
        __builtin_amdgcn_s_sleep(1);
        if ((++sp & 255u) == 0u) { if (xb_ld(&bar[XB_TMO])) break; if (sp > XB_SPIN_CAP) { atomicAdd(&bar[XB_TMO], 1u); break; } }
    }
    nloc = mine > 0u ? mine : 1u; nx = cnt > 0u ? cnt : 1u;
}

__device__ __forceinline__ void xcd_barrier(const XcdBarrier& b) {
    asm volatile("s_waitcnt vmcnt(0)" ::: "memory");
    __syncthreads();
    if (threadIdx.x == 0) {
        unsigned* bar = b.bar;
        __builtin_amdgcn_s_waitcnt(0);
        unsigned nloc = b.st[0], nx = b.st[1];
        if (nloc == 0u) { xcd_barrier_complete(bar, b.x, nloc, nx); b.st[0] = nloc; b.st[1] = nx; }
        const unsigned old = xb_add(&bar[XB_XSUB(b.x)], 1u);
        const unsigned gen = old / nloc;
        if (old + 1u == (gen + 1u) * nloc) {
            __builtin_amdgcn_fence(__ATOMIC_RELEASE, "agent");
            asm volatile("s_waitcnt vmcnt(0)" ::: "memory");
            const unsigned og = xb_add(&bar[XB_TOP], 1u);
            const unsigned tg = og / nx;
            if (og + 1u == (tg + 1u) * nx) xb_add(&bar[XB_TOPGEN], 1u);
            else XB_SPIN(xb_ld(&bar[XB_TOPGEN]) == tg, bar);
            __builtin_amdgcn_fence(__ATOMIC_ACQUIRE, "agent");
            xb_add(&bar[XB_XGEN(b.x)], 1u);
            asm volatile("s_waitcnt vmcnt(0)" ::: "memory");
        } else {
            XB_SPIN(xb_ld(&bar[XB_XGEN(b.x)]) == gen, bar);
            __builtin_amdgcn_fence(__ATOMIC_ACQUIRE, "agent");
            asm volatile("s_waitcnt vmcnt(0)" ::: "memory");
        }
    }
    __syncthreads();
}

struct Ctx {
    LAS unsigned char* lds; int tid, lane, wave, G, bid;
    const float *x_prompt, *x_sample, *mem_prompt, *cwk, *cwv, *sconv, *cmk, *cmv, *npre, *npost, *nmem, *w_in, *conv_w, *sinks, *w_mem, *w_out;
    float* out; unsigned char* ws;
    bf16 *W1T, *W2T, *WMT, *MEMB, *MKV, *XB, *MIX, *Z; float *RS, *RSM, *Y;
};

__device__ __forceinline__ void p0_transpose_item(const float* W, const float* g, int K, int N, bf16* WT, LAS float* scr, int item, int lane) {
    const int nblk = N / 32, kb = item / nblk, nb = item % nblk, k0 = 64 * kb, n0 = 32 * nb;
#pragma unroll 8
    for (int i = 0; i < 32; ++i) { const int kk = 2 * i + (lane >> 5); const float sc = g ? g[k0 + kk] : 1.0f; scr[kk * 33 + (lane & 31)] = W[(size_t)(k0 + kk) * N + n0 + (lane & 31)] * sc; }
    LDS_WAIT(); asm volatile("" ::: "memory");
    const int c = lane & 7;
#pragma unroll
    for (int j = 0; j < 4; ++j) { const int n = (lane >> 3) + 8 * j; const LAS float* s = scr + (8 * c) * 33 + n;
        u32x4 o; o.x = pk2(s[0 * 33], s[1 * 33]); o.y = pk2(s[2 * 33], s[3 * 33]); o.z = pk2(s[4 * 33], s[5 * 33]); o.w = pk2(s[6 * 33], s[7 * 33]);
        *(u32x4*)(WT + (size_t)(n0 + n) * K + k0 + 8 * c) = o; }
    LDS_WAIT(); asm volatile("" ::: "memory");
}
__device__ __forceinline__ void row_to_bf16_rs(const float* xrow, bf16* orow, float* rs, int lane) {
    const f32x4* xr = (const f32x4*)xrow + lane; f32x4 v[4]; float s = 0.f;
#pragma unroll
    for (int j = 0; j < 4; ++j) { v[j] = xr[64 * j]; s += (v[j].x * v[j].x + v[j].y * v[j].y) + (v[j].z * v[j].z + v[j].w * v[j].w); }
    s = wave_sum(s);
    if (lane == 0) *rs = 1.0f / sqrtf(s * (1.0f / D) + RMS_EPS);
    u32x2* o8 = (u32x2*)orow + lane;
#pragma unroll
    for (int j = 0; j < 4; ++j) { u32x2 w; w.x = pk2(v[j].x, v[j].y); w.y = pk2(v[j].z, v[j].w); o8[64 * j] = w; }
}
__device__ __forceinline__ void p0_prologue(Ctx& F) {
    LAS float* scr = (LAS float*)(F.lds + F.wave * 16384);
    const int gw = F.bid * NWAVES + F.wave, NGW = F.G * NWAVES;
    constexpr int I_1 = (D / 64) * (IND / 32), I_2 = (D / 64) * (D / 32), I_M = (D / 64) * (512 / 32), I_L = I_1 + I_2 + I_M;
    for (int it = gw; it < NL * I_L; it += NGW) {
        const int l = it / I_L; int r = it % I_L;
        if (r < I_1) { p0_transpose_item(F.w_in + (size_t)l * D * IND, F.npre + l * D, D, IND, F.W1T + (size_t)l * IND * D, scr, r, F.lane); continue; } r -= I_1;
        if (r < I_2) { p0_transpose_item(F.w_out + (size_t)l * D * D, nullptr, D, D, F.W2T + (size_t)l * D * D, scr, r, F.lane); continue; } r -= I_2;
        p0_transpose_item(F.w_mem + (size_t)l * D * 512, F.nmem + l * D, D, 512, F.WMT + (size_t)l * 512 * D, scr, r, F.lane);
    }
    for (int m = gw; m < M + 512; m += NGW) {
        if (m < M) { const float* src = m < MP ? F.x_prompt + (size_t)m * D : F.x_sample + (size_t)(m - MP) * D; row_to_bf16_rs(src, F.XB + (size_t)m * D, F.RS + m, F.lane); }
        else { const int mm = m - M; row_to_bf16_rs(F.mem_prompt + (size_t)mm * D, F.MEMB + (size_t)mm * D, F.RSM + mm, F.lane); }
    }
}

template <int NKB, int MODE>
__device__ __forceinline__ void attn_core(const bf16x8 (&qf)[4], const LAS unsigned char* Kl, int kcs, const LAS unsigned char* Vl, int vhs, float sink2, int nskip, LAS unsigned char* ost, int lane) {
    const int r32 = lane & 31, h = lane >> 5;
    f32x16 s[NKB];
#pragma unroll
    for (int kb = 0; kb < NKB; ++kb) { f32x16 acc = {};
#pragma unroll
        for (int ds = 0; ds < 4; ++ds) { const bf16x8 kf = *(const LAS bf16x8*)(Kl + (2 * ds + h) * kcs + (32 * kb + r32) * 16); acc = __builtin_amdgcn_mfma_f32_32x32x16_bf16(kf, qf[ds], acc, 0, 0, 0); }
        s[kb] = acc; }
    const float C2 = 0.125f * LOG2E, NEG = -INFINITY;
    float mx = sink2; const int t = r32 & 7;
#pragma unroll
    for (int kb = 0; kb < NKB; ++kb)
#pragma unroll
        for (int r = 0; r < 16; ++r) { float v = s[kb][r] * C2; const int key = crow(r, h); bool valid = true;
            if (MODE == 1) { if (kb == 0) valid = key > r32; if (kb == NKB - 1) valid = key <= r32; if (kb < nskip) valid = false; }
            if (MODE == 2) { if (kb == 0) valid = key > t; if (kb == NKB - 1) valid = key <= t; }
            v = valid ? v : NEG; s[kb][r] = v; mx = fmaxf(mx, v); }
    mx = fmaxf(mx, __shfl_xor(mx, 32));
    float sum = 0.f;
#pragma unroll
    for (int kb = 0; kb < NKB; ++kb)
#pragma unroll
        for (int r = 0; r < 16; ++r) { const float p = __builtin_amdgcn_exp2f(s[kb][r] - mx); s[kb][r] = p; sum += p; }
    sum += __shfl_xor(sum, 32); sum += __builtin_amdgcn_exp2f(sink2 - mx);
    const float inv = 1.0f / sum;
    f32x16 o[2]; o[0] = f32x16{}; o[1] = f32x16{};
    const LAS unsigned char* vb = Vl + ((lane >> 4) & 1) * 32 + (lane & 3) * 8 + (4 * h + ((lane & 15) >> 2)) * 64;
#pragma unroll
    for (int kb = 0; kb < NKB; ++kb)
#pragma unroll
        for (int ss = 0; ss < 2; ++ss) {
            u32x4 pw; pw.x = pk2(s[kb][8 * ss + 0], s[kb][8 * ss + 1]); pw.y = pk2(s[kb][8 * ss + 2], s[kb][8 * ss + 3]); pw.z = pk2(s[kb][8 * ss + 4], s[kb][8 * ss + 5]); pw.w = pk2(s[kb][8 * ss + 6], s[kb][8 * ss + 7]);
            const bf16x8 pb = __builtin_bit_cast(bf16x8, pw);
#pragma unroll
            for (int d0 = 0; d0 < 2; ++d0) { const LAS unsigned char* p = vb + d0 * vhs + (32 * kb + 16 * ss) * 64; const s16x4 lo = vtr(p), hi = vtr(p + 512);
                const bf16x8 va = {lo[0], lo[1], lo[2], lo[3], hi[0], hi[1], hi[2], hi[3]};
                o[d0] = __builtin_amdgcn_mfma_f32_32x32x16_bf16(va, pb, o[d0], 0, 0, 0); } }
#pragma unroll
    for (int d0 = 0; d0 < 2; ++d0)
#pragma unroll
        for (int g4 = 0; g4 < 4; ++g4) { u32x2 w; w.x = pk2(o[d0][4 * g4] * inv, o[d0][4 * g4 + 1] * inv); w.y = pk2(o[d0][4 * g4 + 2] * inv, o[d0][4 * g4 + 3] * inv);
            *(LAS u32x2*)(ost + r32 * 144 + (32 * d0 + 8 * g4 + 4 * h) * 2) = w; }
    LDS_WAIT(); asm volatile("" ::: "memory");
}
template <int RM> __device__ __forceinline__ int rm_row(int rowbase, int q) { return RM == 0 ? rowbase + q : rowbase + (q & 7); }
template <int RM> __device__ __forceinline__ int rm_col(int q) { return RM == 1 ? 64 * (q >> 3) : 0; }
template <int RM> __device__ __forceinline__ void load_q(bf16x8 (&qf)[4], const bf16* Z, int rowbase, int qcol, int lane) {
    const int q = lane & 31, h = lane >> 5; const bf16* p = Z + (size_t)rm_row<RM>(rowbase, q) * IND + qcol + rm_col<RM>(q) + 8 * h;
#pragma unroll
    for (int ds = 0; ds < 4; ++ds) qf[ds] = *(const bf16x8*)(p + 16 * ds);
}
template <int RM> __device__ __forceinline__ void store_o(const bf16* Z, bf16* MIX, int rowbase, int gcol, int mcol, const LAS unsigned char* ost, int lane) {
#pragma unroll
    for (int i = 0; i < 4; ++i) { const int q = i * 8 + (lane >> 3), ch = lane & 7;
        if (RM == 2 && q >= 8) continue;
        const u32x4 ov = *(const LAS u32x4*)(ost + q * 144 + ch * 16);
        const int row = rm_row<RM>(rowbase, q), ca = rm_col<RM>(q);
        const u32x4 gv = *(const u32x4*)(Z + (size_t)row * IND + gcol + ca + 8 * ch);
        u32x4 w;
        w.x = pk2(bflo(gv.x) * bflo(ov.x), bfhi(gv.x) * bfhi(ov.x)); w.y = pk2(bflo(gv.y) * bflo(ov.y), bfhi(gv.y) * bfhi(ov.y));
        w.z = pk2(bflo(gv.z) * bflo(ov.z), bfhi(gv.z) * bfhi(ov.z)); w.w = pk2(bflo(gv.w) * bflo(ov.w), bfhi(gv.w) * bfhi(ov.w));
        *(u32x4*)(MIX + (size_t)row * D + mcol + ca + 8 * ch) = w; }
    LDS_WAIT(); asm volatile("" ::: "memory");
}

constexpr int AL_K = 0, AL_V = 49152, AL_OST = 98304;
constexpr int KCS_P = 256 * 16 + 16, VHS_P = 256 * 64 + 64;
constexpr int KCS_S = 160 * 16 + 16, VHS_S = 160 * 64 + 64, KS_S = 8 * KCS_S, VS_S = 2 * VHS_S;
static_assert(8 * KCS_P <= AL_V - AL_K && 2 * VHS_P <= AL_OST - AL_V && 2 * KS_S <= AL_V && 2 * VS_S <= AL_OST - AL_V && AL_OST + 8 * 4608 <= LDS_BYTES, "mixer LDS map");

__device__ __forceinline__ void put_k(LAS unsigned char* Kl, int kcs, int key, int c, u32x4 v) { *(LAS u32x4*)(Kl + c * kcs + key * 16) = v; }
__device__ __forceinline__ void put_v(LAS unsigned char* Vl, int vhs, int key, int c, u32x4 v) { *(LAS u32x4*)(Vl + (c >> 2) * vhs + key * 64 + (c & 3) * 16) = v; }
__device__ __forceinline__ u32x4 cvt8(f32x4 a, f32x4 b) { u32x4 w; w.x = pk2(a.x, a.y); w.y = pk2(a.z, a.w); w.z = pk2(b.x, b.y); w.w = pk2(b.z, b.w); return w; }

__device__ __forceinline__ void unit_swa_prompt(Ctx& F, int l, int unit) {
    const int i = unit & 63, kvh = (unit >> 6) & 1, b = unit >> 7;
    LAS unsigned char* Kl = F.lds + AL_K; LAS unsigned char* Vl = F.lds + AL_V;
    const int row0 = b * SEQ + 128 * (i - 1);
#pragma unroll
    for (int it = 0; it < 4; ++it) { const int id = F.tid + 512 * it, key = id >> 3, c = id & 7; u32x4 kv = {0u, 0u, 0u, 0u}, vv = {0u, 0u, 0u, 0u};
        if (i > 0 || key >= 128) { const bf16* zr = F.Z + (size_t)(row0 + key) * IND + kvh * 64 + 8 * c; kv = *(const u32x4*)(zr + ZC_K); vv = *(const u32x4*)(zr + ZC_V); }
        put_k(Kl, KCS_P, key, c, kv); put_v(Vl, VHS_P, key, c, vv); }
    if (i == 63) {
#pragma unroll
        for (int it = 0; it < 2; ++it) { const int id = F.tid + 512 * it, j = id >> 3, c = id & 7; const bf16* zr = F.Z + (size_t)(b * SEQ + SEQ - 128 + j) * IND + kvh * 64 + 8 * c;
            const u32x4 kv = *(const u32x4*)(zr + ZC_K), vv = *(const u32x4*)(zr + ZC_V); const size_t o = ((size_t)((l * 2 + b) * 128 + j)) * 128 + kvh * 64 + 8 * c;
            float* ok = F.out + O_WKP + o; float* ov = F.out + O_WVP + o;
            *(f32x4*)ok = (f32x4){bflo(kv.x), bfhi(kv.x), bflo(kv.y), bfhi(kv.y)}; *(f32x4*)(ok + 4) = (f32x4){bflo(kv.z), bfhi(kv.z), bflo(kv.w), bfhi(kv.w)};
            *(f32x4*)ov = (f32x4){bflo(vv.x), bfhi(vv.x), bflo(vv.y), bfhi(vv.y)}; *(f32x4*)(ov + 4) = (f32x4){bflo(vv.z), bfhi(vv.z), bflo(vv.w), bfhi(vv.w)}; }
    }
    __syncthreads();
    LAS unsigned char* ost = F.lds + AL_OST + F.wave * 4608;
#pragma unroll 1
    for (int tk = F.wave; tk < 16; tk += 8) { const int g = tk & 3, sb = tk >> 2, head = kvh * 4 + g, rowbase = b * SEQ + 128 * i + 32 * sb;
        bf16x8 qf[4]; load_q<0>(qf, F.Z, rowbase, ZC_Q + head * 64, F.lane);
        const float sink2 = F.sinks[l * 8 + head] * LOG2E;
        attn_core<5, 1>(qf, Kl + sb * 32 * 16, KCS_P, Vl + sb * 32 * 64, VHS_P, sink2, i == 0 ? 4 - sb : 0, ost, F.lane);
        store_o<0>(F.Z, F.MIX, rowbase, ZC_AG + head * 64, MC_B + head * 64, ost, F.lane); }
    __syncthreads();
}
__device__ __forceinline__ void unit_mem_prompt(Ctx& F, int l, int unit) {
    const int jb = unit & 31, mh = (unit >> 5) & 3, b = unit >> 7;
    LAS unsigned char* Kl = F.lds + AL_K; LAS unsigned char* Vl = F.lds + AL_V;
#pragma unroll
    for (int it = 0; it < 4; ++it) { const int id = F.tid + 512 * it, key = id >> 3, c = id & 7; const bf16* mr = F.MKV + ((size_t)(l * 512 + b * 256 + key)) * 512 + mh * 64 + 8 * c;
        put_k(Kl, KCS_P, key, c, *(const u32x4*)mr); put_v(Vl, VHS_P, key, c, *(const u32x4*)(mr + 256)); }
    __syncthreads();
    LAS unsigned char* ost = F.lds + AL_OST + F.wave * 4608;
    const int rowbase = b * SEQ + 256 * jb + 32 * F.wave;
    bf16x8 qf[4]; load_q<0>(qf, F.Z, rowbase, ZC_MQ + mh * 64, F.lane);
    attn_core<8, 0>(qf, Kl, KCS_P, Vl, VHS_P, -INFINITY, 0, ost, F.lane);
    store_o<0>(F.Z, F.MIX, rowbase, ZC_MG + mh * 64, MC_C + mh * 64, ost, F.lane);
    __syncthreads();
}
__device__ __forceinline__ void unit_swa_sample(Ctx& F, int l, int n) {
    LAS unsigned char* Kl = F.lds + AL_K; LAS unsigned char* Vl = F.lds + AL_V;
    const size_t cbase = ((size_t)(l * NB + n)) * 128 * 128;
#pragma unroll
    for (int it = 0; it < 4; ++it) { const int id = F.tid + 512 * it, c = id & 7, kvh = (id >> 3) & 1, j = id >> 4; const size_t off = cbase + (size_t)j * 128 + kvh * 64 + 8 * c;
        const f32x4 k0 = *(const f32x4*)(F.cwk + off), k1 = *(const f32x4*)(F.cwk + off + 4), v0 = *(const f32x4*)(F.cwv + off), v1 = *(const f32x4*)(F.cwv + off + 4);
        put_k(Kl + kvh * KS_S, KCS_S, j, c, cvt8(k0, k1)); put_v(Vl + kvh * VS_S, VHS_S, j, c, cvt8(v0, v1));
        if (j >= 8) { const size_t oo = off - 8 * 128; *(f32x4*)(F.out + O_WKS + oo) = k0; *(f32x4*)(F.out + O_WKS + oo + 4) = k1; *(f32x4*)(F.out + O_WVS + oo) = v0; *(f32x4*)(F.out + O_WVS + oo + 4) = v1; } }
    if (F.tid < 256) { const int isv = F.tid >> 7, id = F.tid & 127, c = id & 7, kvh = (id >> 3) & 1, t = id >> 4;
        const u32x4 w = *(const u32x4*)(F.Z + (size_t)(MP + n * TS + t) * IND + (isv ? ZC_V : ZC_K) + kvh * 64 + 8 * c);
        if (isv) put_v(Vl + kvh * VS_S, VHS_S, 128 + t, c, w); else put_k(Kl + kvh * KS_S, KCS_S, 128 + t, c, w);
        float* o = F.out + (isv ? O_WVS : O_WKS) + cbase + (size_t)(120 + t) * 128 + kvh * 64 + 8 * c;
        *(f32x4*)o = (f32x4){bflo(w.x), bfhi(w.x), bflo(w.y), bfhi(w.y)}; *(f32x4*)(o + 4) = (f32x4){bflo(w.z), bfhi(w.z), bflo(w.w), bfhi(w.w)}; }
    for (int id = F.tid; id < 24 * 2 * 8; id += 512) { const int c = id & 7, kvh = (id >> 3) & 1, j = 136 + (id >> 4); const u32x4 zz = {0u, 0u, 0u, 0u};
        put_k(Kl + kvh * KS_S, KCS_S, j, c, zz); put_v(Vl + kvh * VS_S, VHS_S, j, c, zz); }
    __syncthreads();
    if (F.wave < 2) { const int kvh = F.wave; LAS unsigned char* ost = F.lds + AL_OST + F.wave * 4608; const int rowbase = MP + n * TS;
        bf16x8 qf[4]; load_q<1>(qf, F.Z, rowbase, ZC_Q + kvh * 256, F.lane);
        const float sink2 = F.sinks[l * 8 + kvh * 4 + ((F.lane & 31) >> 3)] * LOG2E;
        attn_core<5, 2>(qf, Kl + kvh * KS_S, KCS_S, Vl + kvh * VS_S, VHS_S, sink2, 0, ost, F.lane);
        store_o<1>(F.Z, F.MIX, rowbase, ZC_AG + kvh * 256, MC_B + kvh * 256, ost, F.lane); }
    __syncthreads();
}
__device__ __forceinline__ void unit_mem_sample(Ctx& F, int l, int unit) {
    const int mh = unit & 3, n = unit >> 2;
    LAS unsigned char* Kl = F.lds + AL_K; LAS unsigned char* Vl = F.lds + AL_V;
    const size_t cbase = ((size_t)(l * NB + n)) * 256 * 256 + mh * 64;
#pragma unroll
    for (int it = 0; it < 4; ++it) { const int id = F.tid + 512 * it, key = id >> 3, c = id & 7; const size_t off = cbase + (size_t)key * 256 + 8 * c;
        const f32x4 k0 = *(const f32x4*)(F.cmk + off), k1 = *(const f32x4*)(F.cmk + off + 4), v0 = *(const f32x4*)(F.cmv + off), v1 = *(const f32x4*)(F.cmv + off + 4);
        put_k(Kl, KCS_P, key, c, cvt8(k0, k1)); put_v(Vl, VHS_P, key, c, cvt8(v0, v1)); }
    __syncthreads();
    if (F.wave == 0) { LAS unsigned char* ost = F.lds + AL_OST; const int rowbase = MP + n * TS;
        bf16x8 qf[4]; load_q<2>(qf, F.Z, rowbase, ZC_MQ + mh * 64, F.lane);
        attn_core<8, 0>(qf, Kl, KCS_P, Vl, VHS_P, -INFINITY, 0, ost, F.lane);
        store_o<2>(F.Z, F.MIX, rowbase, ZC_MG + mh * 64, MC_C + mh * 64, ost, F.lane); }
    __syncthreads();
}
__device__ __forceinline__ void conv_u(const bf16* zr, int ch, float (&u)[8]) {
    const u32x4 a = *(const u32x4*)(zr + ZC_CC + ch), b = *(const u32x4*)(zr + ZC_CH + ch);
    u[0] = bflo(a.x) * bflo(b.x); u[1] = bfhi(a.x) * bfhi(b.x); u[2] = bflo(a.y) * bflo(b.y); u[3] = bfhi(a.y) * bfhi(b.y);
    u[4] = bflo(a.z) * bflo(b.z); u[5] = bfhi(a.z) * bfhi(b.z); u[6] = bflo(a.w) * bflo(b.w); u[7] = bfhi(a.w) * bfhi(b.w);
}
__device__ __forceinline__ void conv_items(Ctx& F, int l) {
    const int gt = F.bid * 512 + F.tid, NT = F.G * 512;
    const float* cw = F.conv_w + l * 3 * 256;
#pragma unroll 1
    for (int it = gt; it < M * 32; it += NT) { const int r = it >> 5, ch = (it & 31) * 8; const bf16* zr = F.Z + (size_t)r * IND;
        float u0[8], u1[8], u2[8];
        conv_u(zr, ch, u0);
        int t; const float* st = nullptr;
        if (r < MP) t = r & (SEQ - 1); else { const int s = r - MP; t = s & 7; st = F.sconv + ((size_t)(l * NB + (s >> 3))) * 512 + ch; }
        if (t >= 1) conv_u(zr - IND, ch, u1); else {
#pragma unroll
            for (int e = 0; e < 8; ++e) u1[e] = st ? st[256 + e] : 0.f; }
        if (t >= 2) conv_u(zr - 2 * IND, ch, u2); else {
#pragma unroll
            for (int e = 0; e < 8; ++e) u2[e] = st ? st[t * 256 + e] : 0.f; }
        const u32x4 cb = *(const u32x4*)(zr + ZC_CB + ch), gs = *(const u32x4*)(zr + ZC_CG + ch);
        const float cbf[8] = {bflo(cb.x), bfhi(cb.x), bflo(cb.y), bfhi(cb.y), bflo(cb.z), bfhi(cb.z), bflo(cb.w), bfhi(cb.w)};
        const float gsf[8] = {bflo(gs.x), bfhi(gs.x), bflo(gs.y), bfhi(gs.y), bflo(gs.z), bfhi(gs.z), bflo(gs.w), bfhi(gs.w)};
        float o[8];
#pragma unroll
        for (int e = 0; e < 8; ++e) { const float cv = cw[ch + e] * u2[e] + cw[256 + ch + e] * u1[e] + cw[512 + ch + e] * u0[e]; o[e] = gsf[e] * cbf[e] * cv; }
        u32x4 w; w.x = pk2(o[0], o[1]); w.y = pk2(o[2], o[3]); w.z = pk2(o[4], o[5]); w.w = pk2(o[6], o[7]);
        *(u32x4*)(F.MIX + (size_t)r * D + MC_A + ch) = w;
        float* so = nullptr;
        if (r < MP) { if (t >= SEQ - 2) so = F.out + O_CVP + ((size_t)((l * 2 + (r >> 13)) * 2 + (t - (SEQ - 2)))) * 256 + ch; }
        else { if (t >= TS - 2) so = F.out + O_CVS + ((size_t)((l * NB + ((r - MP) >> 3)) * 2 + (t - (TS - 2)))) * 256 + ch; }
        if (so) { *(f32x4*)so = (f32x4){u0[0], u0[1], u0[2], u0[3]}; *(f32x4*)(so + 4) = (f32x4){u0[4], u0[5], u0[6], u0[7]}; }
    }
}
__device__ __forceinline__ void mix_phase(Ctx& F, int l) {
    for (int u = F.bid; u < 256; u += F.G) unit_swa_prompt(F, l, u);
    for (int u = F.bid; u < 256; u += F.G) unit_mem_prompt(F, l, u);
    for (int u = F.bid; u < NB; u += F.G) unit_swa_sample(F, l, u);
    for (int u = F.bid; u < NB * 4; u += F.G) unit_mem_sample(F, l, u);
    conv_items(F, l);
}
__device__ __forceinline__ void norm_phase(Ctx& F, int l) {
    const int gw = F.bid * NWAVES + F.wave, NGW = F.G * NWAVES;
    const f32x4* gp = (const f32x4*)(F.npost + l * D) + F.lane;
    f32x4 g[4];
#pragma unroll
    for (int j = 0; j < 4; ++j) g[j] = gp[64 * j];
    for (int m = gw; m < M; m += NGW) {
        const float* xin = (l == 0) ? (m < MP ? F.x_prompt + (size_t)m * D : F.x_sample + (size_t)(m - MP) * D) : F.out + O_X + (size_t)m * D;
        const f32x4* yr = (const f32x4*)(F.Y + (size_t)m * D) + F.lane; const f32x4* xr = (const f32x4*)xin + F.lane;
        f32x4 y[4], x[4]; float s = 0.f;
#pragma unroll
        for (int j = 0; j < 4; ++j) { y[j] = yr[64 * j]; x[j] = xr[64 * j]; s += (y[j].x * y[j].x + y[j].y * y[j].y) + (y[j].z * y[j].z + y[j].w * y[j].w); }
        const float r = 1.0f / sqrtf(wave_sum(s) * (1.0f / D) + RMS_EPS); float s2 = 0.f;
        f32x4* xo = (f32x4*)(F.out + O_X + (size_t)m * D) + F.lane; u32x2* o8 = (u32x2*)(F.XB + (size_t)m * D) + F.lane;
#pragma unroll
        for (int j = 0; j < 4; ++j) { x[j] = x[j] + (y[j] * r) * g[j]; xo[64 * j] = x[j]; s2 += (x[j].x * x[j].x + x[j].y * x[j].y) + (x[j].z * x[j].z + x[j].w * x[j].w);
            u32x2 w; w.x = pk2(x[j].x, x[j].y); w.y = pk2(x[j].z, x[j].w); o8[64 * j] = w; }
        s2 = wave_sum(s2);
        if (F.lane == 0) F.RS[m] = 1.0f / sqrtf(s2 * (1.0f / D) + RMS_EPS);
    }
}

struct Args { const float* in[16]; float* out; unsigned char* ws; };
__global__ void __launch_bounds__(NWAVES * 64, 2) hymba_fwd(Args args) {
    extern __shared__ __attribute__((aligned(16))) unsigned char lds[];
    Ctx F;
    F.lds = (LAS unsigned char*)lds; F.tid = threadIdx.x; F.lane = F.tid & 63; F.wave = __builtin_amdgcn_readfirstlane(F.tid >> 6); F.G = gridDim.x; F.bid = blockIdx.x;
    F.x_prompt = args.in[0]; F.x_sample = args.in[1]; F.mem_prompt = args.in[2]; F.cwk = args.in[3]; F.cwv = args.in[4]; F.sconv = args.in[5]; F.cmk = args.in[6]; F.cmv = args.in[7];
    F.npre = args.in[8]; F.npost = args.in[9]; F.nmem = args.in[10]; F.w_in = args.in[11]; F.conv_w = args.in[12]; F.sinks = args.in[13]; F.w_mem = args.in[14]; F.w_out = args.in[15];
    F.out = args.out; F.ws = args.ws;
    unsigned char* ws = args.ws;
    F.W1T = (bf16*)(ws + WS_W1T); F.W2T = (bf16*)(ws + WS_W2T); F.WMT = (bf16*)(ws + WS_WMT); F.MEMB = (bf16*)(ws + WS_MEMB); F.MKV = (bf16*)(ws + WS_MKV);
    if (threadIdx.x < 64) ((LAS unsigned*)(lds + LDS_MISC))[threadIdx.x] = 0u;
    __syncthreads();
    const XcdBarrier bar = xcd_barrier_post((unsigned*)(ws + WS_CTL) + 1024, (volatile LAS unsigned*)(lds + LDS_MISC));
#define GRID_SYNC() xcd_barrier(bar)
    F.XB = (bf16*)(ws + WS_XB); F.MIX = (bf16*)(ws + WS_MIX); F.Z = (bf16*)(ws + WS_Z); F.RS = (float*)(ws + WS_RS); F.RSM = (float*)(ws + WS_RSM); F.Y = (float*)(ws + WS_Y);

#define RELANE() do { int t_ = threadIdx.x; asm volatile("" : "+v"(t_)); F.tid = t_; F.lane = t_ & 63; } while (0)
    p0_prologue(F);
    GRID_SYNC();
#pragma unroll 1
    for (int l = 0; l < NL; ++l) {
        {
            pg8::Gemm g{F.XB, F.W1T + (size_t)l * IND * D, M, IND, D}; pg8::StaticOrder S; S.init(M, IND, F.G, F.bid);
            pg8::EpiZ E{F.Z, F.RS, IND};
            pg8::gemm_phase<pg8::EpiZ, pg8::StaticOrder, true, true>(F.lds, g, S, E);
            if (l == 0) {
                pg8::Gemm gm{F.MEMB, F.WMT, 512, NL * 512, D}; pg8::MkvOrder SM{F.bid - (F.G - 16)};
                pg8::EpiMKV EM{F.out + O_MKP, O_MVP - O_MKP, F.MKV, F.RSM};
                pg8::gemm_phase<pg8::EpiMKV, pg8::MkvOrder, true, true>(F.lds, gm, SM, EM);
            }
        }
        GRID_SYNC();
        RELANE(); mix_phase(F, l);
        GRID_SYNC();
        {
            pg8::Gemm g{F.MIX, F.W2T + (size_t)l * D * D, M, D, D}; pg8::StaticOrder S; S.init(M, D, F.G, F.bid);
            pg8::EpiY E{F.Y, D};
            pg8::gemm_phase<pg8::EpiY, pg8::StaticOrder, true, true>(F.lds, g, S, E);
        }
        GRID_SYNC();
        RELANE(); norm_phase(F, l);
        if (l + 1 < NL) GRID_SYNC();
    }
}

extern "C" void kernel_launch(void* const* d_in, const int* in_sizes, int n_in, void* d_out, int out_size, void* d_ws, size_t ws_size, hipStream_t stream) {
    static int grid = 0;
    if (grid == 0) {
        if (n_in != 16 || in_sizes[0] != MP * D || (size_t)out_size != O_END || ws_size < WS_END) {
            fprintf(stderr, "kernel_launch: unexpected shapes: n_in %d in0 %d out %d (want %zu) ws %zu (want >= %zu); nothing launched\n", n_in, n_in > 0 ? in_sizes[0] : -1, out_size, (size_t)O_END, ws_size, (size_t)WS_END); grid = -1; return; }
        int dev = 0, cus = 0, per_cu = 0;
        if (hipGetDevice(&dev) != hipSuccess || hipDeviceGetAttribute(&cus, hipDeviceAttributeMultiprocessorCount, dev) != hipSuccess) { grid = -1; return; }
        if (hipFuncSetAttribute((const void*)hymba_fwd, hipFuncAttributeMaxDynamicSharedMemorySize, LDS_BYTES) != hipSuccess) { fprintf(stderr, "kernel_launch: hipFuncSetAttribute failed\n"); grid = -1; return; }
        if (hipOccupancyMaxActiveBlocksPerMultiprocessor(&per_cu, (const void*)hymba_fwd, NWAVES * 64, LDS_BYTES) != hipSuccess || per_cu < 1) { fprintf(stderr, "kernel_launch: occupancy query says %d blocks per CU; nothing launched\n", per_cu); (void)hipGetLastError(); grid = -1; return; }
        grid = cus;
        fprintf(stderr, "kernel_launch: %d CUs, occupancy %d per CU, grid %d\n", cus, per_cu, grid);
    }
    if (grid < 0) return;
    if (hipMemsetAsync((char*)d_ws + WS_CTL, 0, CTL_ZERO_BYTES, stream) != hipSuccess) { fprintf(stderr, "kernel_launch: hipMemsetAsync failed\n"); return; }
    Args a{};
    for (int i = 0; i < 16; ++i) a.in[i] = (const float*)d_in[i];
    a.out = (float*)d_out; a.ws = (unsigned char*)d_ws;
    void* args[] = {&a};
    const hipError_t e = hipLaunchCooperativeKernel((const void*)hymba_fwd, dim3(grid), dim3(NWAVES * 64), args, LDS_BYTES, stream);
    if (e != hipSuccess) fprintf(stderr, "kernel_launch: cooperative launch failed: %s (grid %d)\n", hipGetErrorString(e), grid);
}
```
